# Optimizing an MI355X kernel written in HIP

```python
import math
import jax
import jax.numpy as jnp
from jax import lax
import numpy as np

D_MODEL = 1024
BATCH = 4
SEQ = 8192
DEPTH = 4

GRID_W = 64
CTX_LEN = 256
Q_BLOCK = 128
ROPE_BASE = 10000.0
LN_EPS = 1e-5
RMS_EPS = 1e-6

MLA_HEADS = 8
MLA_Q_RANK = 256
MLA_KV_RANK = 128
MLA_NOPE_DIM = 64
MLA_ROPE_DIM = 32
MLA_V_DIM = 64
MLA_SCALE = (MLA_NOPE_DIM + MLA_ROPE_DIM) ** -0.5

HG_HEADS = 4
HG_KEY_DIM = 128
HG_VAL_DIM = 128
HG_CHUNK = 64
HG_SCALE = HG_KEY_DIM ** -0.5

DIFF_HEADS = 4
DIFF_HEAD_DIM = 64
DIFF_V_DIM = 2 * DIFF_HEAD_DIM
DIFF_SCALE = DIFF_HEAD_DIM ** -0.5

BRANCH_WIDTH = 512
N_BRANCHES = 3
FF_HIDDEN = -(-8 * D_MODEL // (3 * 256)) * 256
DEEPNORM_ALPHA = (2 * DEPTH) ** 0.25
DEEPNORM_BETA = (8 * DEPTH) ** -0.25

IN_SPLITS = (
    MLA_Q_RANK, MLA_KV_RANK, MLA_ROPE_DIM,
    HG_HEADS * HG_KEY_DIM, HG_HEADS * HG_KEY_DIM,
    HG_HEADS * HG_KEY_DIM, HG_HEADS * HG_VAL_DIM,
    HG_HEADS * HG_VAL_DIM,
    DIFF_HEADS * 2 * DIFF_HEAD_DIM, DIFF_HEADS * 2 * DIFF_HEAD_DIM, DIFF_HEADS * DIFF_V_DIM,
)
IN_WIDTH = sum(IN_SPLITS)

kernel_name = 'hybrid_mla_hgrn2_diffattn_block'


def _layer_norm(x, g, b):
    xf = x.astype(jnp.float32)
    mu = jnp.mean(xf, axis=-1, keepdims=True)
    var = jnp.mean(jnp.square(xf - mu), axis=-1, keepdims=True)
    y = (xf - mu) * lax.rsqrt(var + LN_EPS)
    return (y * g.astype(jnp.float32) + b.astype(jnp.float32)).astype(x.dtype)


def _rms_norm(x, g):
    xf = x.astype(jnp.float32)
    y = xf * lax.rsqrt(jnp.mean(jnp.square(xf), axis=-1, keepdims=True) + RMS_EPS)
    return (y * g.astype(jnp.float32)).astype(x.dtype)


def _post_norm(res, y, g, b):
    return _layer_norm(DEEPNORM_ALPHA * res + y, g, b)


def _axial_rope_tables(rows, rot_dim):
    row, col = jnp.meshgrid(jnp.arange(rows, dtype=jnp.float32), jnp.arange(GRID_W, dtype=jnp.float32), indexing='ij')
    n_freq = rot_dim // 4
    inv_freq = ROPE_BASE ** (-jnp.arange(n_freq, dtype=jnp.float32) / n_freq)
    ang = jnp.concatenate([row.reshape(-1, 1) * inv_freq, col.reshape(-1, 1) * inv_freq], axis=-1)
    return jnp.cos(ang), jnp.sin(ang)


def _rope(x, cos, sin):
    x1, x2 = jnp.split(x, 2, axis=-1)
    cos = cos.astype(x.dtype)
    sin = sin.astype(x.dtype)
    return jnp.concatenate([x1 * cos - x2 * sin, x1 * sin + x2 * cos], axis=-1)


def _split_in(p):
    offsets = [int(o) for o in np.cumsum(IN_SPLITS)[:-1]]
    return jnp.split(p, offsets, axis=-1)


def _heads_to_tokens(o):
    b, h, L, d = o.shape
    return o.transpose(0, 2, 1, 3).reshape(b, L, h * d)


def _query_blocks(fn, q):
    b, h, s, d = q.shape
    nb = s // Q_BLOCK
    qb = jnp.moveaxis(q.reshape(b, h, nb, Q_BLOCK, d), 2, 0)
    ob = lax.map(fn, qb)
    return jnp.moveaxis(ob, 0, 2).reshape(b, h, s, ob.shape[-1])


def _mla_qkv(c_q, c_kv, k_pe, lp, rope):
    b, L, _ = c_q.shape
    q = (_rms_norm(c_q, lp['mla_q_norm']) @ lp['w_uq']).reshape(b, L, MLA_HEADS, MLA_NOPE_DIM + MLA_ROPE_DIM)
    kv = (_rms_norm(c_kv, lp['mla_kv_norm']) @ lp['w_ukv']).reshape(b, L, MLA_HEADS, MLA_NOPE_DIM + MLA_V_DIM)
    q_nope, q_pe = q[..., :MLA_NOPE_DIM], q[..., MLA_NOPE_DIM:]
    k_nope, v = kv[..., :MLA_NOPE_DIM], kv[..., MLA_NOPE_DIM:]
    if rope is not None:
        cos, sin = rope
        q_pe = _rope(q_pe, cos[:, None, :], sin[:, None, :])
        k_pe = _rope(k_pe, cos, sin)
    k_pe = jnp.broadcast_to(k_pe[:, :, None, :], (b, L, MLA_HEADS, MLA_ROPE_DIM))
    q = jnp.concatenate([q_nope, q_pe], axis=-1)
    k = jnp.concatenate([k_nope, k_pe], axis=-1)
    return q.transpose(0, 2, 1, 3), k.transpose(0, 2, 1, 3), v.transpose(0, 2, 1, 3)


def _mla_attend(q, k, v):
    s = jnp.einsum('bhqd,bhkd->bhqk', q, k) * MLA_SCALE
    p = jax.nn.softmax(s.astype(jnp.float32), axis=-1).astype(v.dtype)
    return jnp.einsum('bhqk,bhkd->bhqd', p, v)


def _hgrn2_inputs(q_raw, ff_raw, fb_raw, i_raw, lb_fwd, lb_bwd):
    b, L, _ = q_raw.shape

    def heads(t):
        return t.reshape(b, L, HG_HEADS, -1).transpose(0, 2, 1, 3).astype(jnp.float32)

    def gate(raw, lb):
        lb = lb.astype(jnp.float32).reshape(1, HG_HEADS, 1, HG_KEY_DIM)
        z = heads(raw)
        log_f = jnp.logaddexp(jnp.log(lb), jnp.log1p(-lb) + jax.nn.log_sigmoid(z))
        return (1.0 - lb) * jax.nn.sigmoid(-z), log_f

    q = jax.nn.silu(heads(q_raw)) * HG_SCALE
    k_f, g_f = gate(ff_raw, lb_fwd)
    k_b, g_b = gate(fb_raw, lb_bwd)
    return q, k_f, g_f, k_b, g_b, heads(i_raw)


def _gla_chunk_scan(q, k, v, log_f, s0, emit):
    b, h, L, _ = q.shape
    dv = v.shape[-1]
    n = L // HG_CHUNK

    def to_chunks(t):
        return jnp.moveaxis(t.reshape(b, h, n, HG_CHUNK, t.shape[-1]), 2, 0)

    incl = jnp.tril(jnp.ones((HG_CHUNK, HG_CHUNK), dtype=bool))

    def step(S, inp):
        qc, kc, vc, gc = inp
        cum = jnp.cumsum(gc, axis=2)
        last = cum[:, :, -1, :]
        S_new = jnp.exp(last)[..., None] * S + jnp.einsum('bhsk,bhsv->bhkv', kc * jnp.exp(last[:, :, None, :] - cum), vc)
        if not emit:
            return S_new, None
        rel = jnp.where(incl[:, :, None], cum[:, :, :, None, :] - cum[:, :, None, :, :], -jnp.inf)
        scores = jnp.einsum('bhtk,bhsk,bhtsk->bhts', qc, kc, jnp.exp(rel))
        o = jnp.einsum('bhts,bhsv->bhtv', scores, vc) + jnp.einsum('bhtk,bhkv->bhtv', qc * jnp.exp(cum), S)
        return S_new, o

    S, o = lax.scan(step, s0, (to_chunks(q), to_chunks(k), to_chunks(v), to_chunks(log_f)))
    if not emit:
        return S, None
    return S, jnp.moveaxis(o, 0, 2).reshape(b, h, L, dv)


def _flip(t):
    return t[:, :, ::-1]


def _hgrn2_out(o, g_raw, g_norm):
    b, h, L, dv = o.shape
    o = o.transpose(0, 2, 1, 3).astype(g_raw.dtype)
    g = g_raw.reshape(b, L, HG_HEADS, HG_VAL_DIM)
    return (_rms_norm(o, g_norm) * jax.nn.silu(g)).reshape(b, L, h * dv)


def _diff_qkv(q_raw, k_raw, v_raw, rope):
    b, L, _ = q_raw.shape
    q = q_raw.reshape(b, L, DIFF_HEADS, 2, DIFF_HEAD_DIM)
    k = k_raw.reshape(b, L, DIFF_HEADS, 2, DIFF_HEAD_DIM)
    if rope is not None:
        cos, sin = rope
        q = _rope(q, cos[:, None, None, :], sin[:, None, None, :])
        k = _rope(k, cos[:, None, None, :], sin[:, None, None, :])
    q = q.reshape(b, L, DIFF_HEADS, 2 * DIFF_HEAD_DIM).transpose(0, 2, 1, 3)
    k = k.reshape(b, L, DIFF_HEADS, 2 * DIFF_HEAD_DIM).transpose(0, 2, 1, 3)
    v = v_raw.reshape(b, L, DIFF_HEADS, DIFF_V_DIM).transpose(0, 2, 1, 3)
    return q, k, v


def _diff_attend(q, k, v, lam):
    q1, q2 = q[..., :DIFF_HEAD_DIM], q[..., DIFF_HEAD_DIM:]
    k1, k2 = k[..., :DIFF_HEAD_DIM], k[..., DIFF_HEAD_DIM:]
    p1 = jax.nn.softmax((jnp.einsum('bhqd,bhkd->bhqk', q1, k1) * DIFF_SCALE).astype(jnp.float32), axis=-1)
    p2 = jax.nn.softmax((jnp.einsum('bhqd,bhkd->bhqk', q2, k2) * DIFF_SCALE).astype(jnp.float32), axis=-1)
    return jnp.einsum('bhqk,bhkd->bhqd', (p1 - lam * p2).astype(v.dtype), v)


def _diff_out(o, subln, lam_init):
    b, h, L, d = o.shape
    return (_rms_norm(o.transpose(0, 2, 1, 3), subln) * (1.0 - lam_init)).reshape(b, L, h * d)


def _diff_lambda_init(layer):
    return 0.8 - 0.6 * math.exp(-0.3 * layer)


def _merge(h, ys, lp):
    m = jax.nn.sigmoid(h @ lp['w_gate'][0] + lp['b_gate'][0]) * (ys[0] @ lp['w_branch'][0])
    for i in range(1, N_BRANCHES):
        m = m + jax.nn.sigmoid(h @ lp['w_gate'][i] + lp['b_gate'][i]) * (ys[i] @ lp['w_branch'][i])
    return m @ lp['w_o']


def _swiglu(h, w1, w2):
    gate, up = jnp.split(h @ w1, 2, axis=-1)
    return (jax.nn.silu(gate) * up) @ w2


def _token_mixer(h_x, h_c, lp, lb_fwd, lb_bwd, lam_init, rope_mla, rope_diff, ctx_out):
    px = _split_in(h_x @ lp['w_in'])
    pc = _split_in(h_c @ lp['w_in'])

    q_mc, k_mc, v_mc = _mla_qkv(pc[0], pc[1], pc[2], lp, None)
    q_mx, k_mx, v_mx = _mla_qkv(px[0], px[1], px[2], lp, rope_mla)
    k_m = jnp.concatenate([k_mc, k_mx], axis=2)
    v_m = jnp.concatenate([v_mc, v_mx], axis=2)
    y_mla_x = _heads_to_tokens(_query_blocks(lambda qb: _mla_attend(qb, k_m, v_m), q_mx))

    q_hc, kf_c, gf_c, kb_c, gb_c, v_hc = _hgrn2_inputs(pc[3], pc[4], pc[5], pc[6], lb_fwd, lb_bwd)
    q_hx, kf_x, gf_x, kb_x, gb_x, v_hx = _hgrn2_inputs(px[3], px[4], px[5], px[6], lb_fwd, lb_bwd)
    zeros = jnp.zeros(q_hc.shape[:2] + (HG_KEY_DIM, HG_VAL_DIM), jnp.float32)
    s_f, o_f_c = _gla_chunk_scan(q_hc, kf_c, v_hc, gf_c, zeros, ctx_out)
    s_b, o_b_c = _gla_chunk_scan(_flip(q_hc), _flip(kb_c), _flip(v_hc), _flip(gb_c), zeros, ctx_out)
    _, o_f_x = _gla_chunk_scan(q_hx, kf_x, v_hx, gf_x, s_f, True)
    _, o_b_x = _gla_chunk_scan(_flip(q_hx), _flip(kb_x), _flip(v_hx), _flip(gb_x), s_b, True)
    y_hg_x = _hgrn2_out(o_f_x + _flip(o_b_x), px[7], lp['hg_norm'])

    dl = lp['diff_lambda'].astype(jnp.float32)
    lam = jnp.exp(jnp.sum(dl[0] * dl[1])) - jnp.exp(jnp.sum(dl[2] * dl[3])) + lam_init
    q_dc, k_dc, v_dc = _diff_qkv(pc[8], pc[9], pc[10], None)
    q_dx, k_dx, v_dx = _diff_qkv(px[8], px[9], px[10], rope_diff)
    k_d = jnp.concatenate([k_dc, k_dx], axis=2)
    v_d = jnp.concatenate([v_dc, v_dx], axis=2)
    y_diff_x = _diff_out(_query_blocks(lambda qb: _diff_attend(qb, k_d, v_d, lam), q_dx), lp['diff_subln'], lam_init)

    y_x = _merge(h_x, (y_mla_x, y_hg_x, y_diff_x), lp)
    if not ctx_out:
        return y_x, None
    y_mla_c = _heads_to_tokens(_mla_attend(q_mc, k_mc, v_mc))
    y_hg_c = _hgrn2_out(o_f_c + _flip(o_b_c), pc[7], lp['hg_norm'])
    y_diff_c = _diff_out(_diff_attend(q_dc, k_dc, v_dc, lam), lp['diff_subln'], lam_init)
    y_c = _merge(h_c, (y_mla_c, y_hg_c, y_diff_c), lp)
    return y_x, y_c


def setup_inputs(seed: int = 0) -> dict:
    key = jax.random.key(seed)
    ks = jax.random.split(key, 25)

    def nrm(k, shape, scale):
        return scale * jax.random.normal(k, shape, jnp.float32)

    d = D_MODEL
    return {
        'x': nrm(ks[0], (BATCH, SEQ, d), 1.0),
        'c': nrm(ks[1], (BATCH, d), 1.0),
        'ctx': nrm(ks[2], (BATCH, CTX_LEN, d), 1.0),
        'c_ctx': nrm(ks[3], (d,), 1.0),
        'w_mod': nrm(ks[4], (DEPTH, d, 6 * d), 0.5 * d ** -0.5),
        'b_mod': nrm(ks[5], (DEPTH, 6 * d), 0.01),
        'w_in': nrm(ks[6], (DEPTH, d, IN_WIDTH), d ** -0.5),
        'mla_q_norm': 1.0 + nrm(ks[7], (DEPTH, MLA_Q_RANK), 0.02),
        'mla_kv_norm': 1.0 + nrm(ks[8], (DEPTH, MLA_KV_RANK), 0.02),
        'w_uq': nrm(ks[9], (DEPTH, MLA_Q_RANK, MLA_HEADS * (MLA_NOPE_DIM + MLA_ROPE_DIM)), MLA_Q_RANK ** -0.5),
        'w_ukv': nrm(ks[10], (DEPTH, MLA_KV_RANK, MLA_HEADS * (MLA_NOPE_DIM + MLA_V_DIM)), MLA_KV_RANK ** -0.5),
        'hg_lb_logits': nrm(ks[11], (2, DEPTH, HG_HEADS * HG_KEY_DIM), 0.1),
        'hg_norm': 1.0 + nrm(ks[12], (DEPTH, HG_VAL_DIM), 0.02),
        'diff_lambda': nrm(ks[13], (DEPTH, 4, DIFF_HEAD_DIM), 0.1),
        'diff_subln': 1.0 + nrm(ks[14], (DEPTH, DIFF_V_DIM), 0.02),
        'w_branch': nrm(ks[15], (DEPTH, N_BRANCHES, BRANCH_WIDTH, d), BRANCH_WIDTH ** -0.5),
        'w_gate': nrm(ks[16], (DEPTH, N_BRANCHES, d, d), d ** -0.5),
        'b_gate': nrm(ks[17], (DEPTH, N_BRANCHES, d), 0.01),
        'w_o': nrm(ks[18], (DEPTH, d, d), DEEPNORM_BETA * d ** -0.5),
        'ln1_g': 1.0 + nrm(ks[19], (DEPTH, d), 0.02),
        'ln1_b': nrm(ks[20], (DEPTH, d), 0.01),
        'w_ff1': nrm(ks[21], (DEPTH, d, 2 * FF_HIDDEN), d ** -0.5),
        'w_ff2': nrm(ks[22], (DEPTH, FF_HIDDEN, d), DEEPNORM_BETA * FF_HIDDEN ** -0.5),
        'ln2_g': 1.0 + nrm(ks[23], (DEPTH, d), 0.02),
        'ln2_b': nrm(ks[24], (DEPTH, d), 0.01),
    }


def reference(x, c, ctx, c_ctx, w_mod, b_mod, w_in, mla_q_norm, mla_kv_norm, w_uq, w_ukv, hg_lb_logits, hg_norm,
              diff_lambda, diff_subln, w_branch, w_gate, b_gate, w_o, ln1_g, ln1_b, w_ff1, w_ff2, ln2_g, ln2_b):
    rows = x.shape[1] // GRID_W
    rope_mla = _axial_rope_tables(rows, MLA_ROPE_DIM)
    rope_diff = _axial_rope_tables(rows, DIFF_HEAD_DIM)
    cum = jnp.cumsum(jax.nn.softmax(hg_lb_logits.astype(jnp.float32), axis=1), axis=1)
    lower_bounds = cum - cum[:, :1]
    c_act = jax.nn.silu(c)
    c_ctx_act = jax.nn.silu(c_ctx)
    for l in range(DEPTH):
        ctx_out = l < DEPTH - 1
        lp = {
            'w_in': w_in[l], 'mla_q_norm': mla_q_norm[l], 'mla_kv_norm': mla_kv_norm[l],
            'w_uq': w_uq[l], 'w_ukv': w_ukv[l], 'hg_norm': hg_norm[l],
            'diff_lambda': diff_lambda[l], 'diff_subln': diff_subln[l],
            'w_branch': w_branch[l], 'w_gate': w_gate[l], 'b_gate': b_gate[l], 'w_o': w_o[l],
        }
        sh1, sc1, g1, sh2, sc2, g2 = jnp.split((c_act @ w_mod[l] + b_mod[l])[:, None, :], 6, axis=-1)
        csh1, csc1, cg1, csh2, csc2, cg2 = jnp.split(c_ctx_act @ w_mod[l] + b_mod[l], 6, axis=-1)
        y_x, y_c = _token_mixer(x * (1 + sc1) + sh1, ctx * (1 + csc1) + csh1, lp, lower_bounds[0, l],
                                lower_bounds[1, l], _diff_lambda_init(l), rope_mla, rope_diff, ctx_out)
        x = _post_norm(x, g1 * y_x, ln1_g[l], ln1_b[l])
        x = _post_norm(x, g2 * _swiglu(x * (1 + sc2) + sh2, w_ff1[l], w_ff2[l]), ln2_g[l], ln2_b[l])
        if ctx_out:
            ctx = _post_norm(ctx, cg1 * y_c, ln1_g[l], ln1_b[l])
            ctx = _post_norm(ctx, cg2 * _swiglu(ctx * (1 + csc2) + csh2, w_ff1[l], w_ff2[l]), ln2_g[l], ln2_b[l])
    return x
```

```cpp
#include <hip/hip_runtime.h>
#include <hip/hip_cooperative_groups.h>
#include <cstdio>
namespace cg = cooperative_groups;

#define DI __device__ __forceinline__
typedef unsigned short bf16_t;
typedef __attribute__((ext_vector_type(8))) short bf16x8;
typedef __attribute__((ext_vector_type(4))) short bf16x4;
typedef __attribute__((ext_vector_type(16))) float f32x16;
typedef unsigned u32x4 __attribute__((ext_vector_type(4)));
typedef unsigned u32x2 __attribute__((ext_vector_type(2)));
typedef __bf16 bfv2 __attribute__((ext_vector_type(2)));
typedef float fv2 __attribute__((ext_vector_type(2)));
#define MFMA(a, b, c) __builtin_amdgcn_mfma_f32_32x32x16_bf16((a), (b), (c), 0, 0, 0)

constexpr int D = 1024;
constexpr int NBATCH = 4;
constexpr int SEQ = 8192;
constexpr int CTX = 256;
constexpr int LP = SEQ + CTX;
constexpr int GB = 2;
constexpr int NGRP = NBATCH / GB;
constexpr int TG = GB * LP;
constexpr int MT = TG / 128;
constexpr int DEPTH = 4;
constexpr int INW = 4512;
constexpr int INWP = 4608;
constexpr int FFH = 2816;
constexpr int NRNG = 33;
constexpr float LOG2E = 1.4426950408889634f;
constexpr float MLA_QSCALE = 0.10206207261596577f * LOG2E;
constexpr float DIFF_QSCALE = 0.125f * LOG2E;
constexpr float HG_SCALE = 0.08838834764831845f;
constexpr float ALPHA = 1.681792830507429f;
constexpr float LOG2_10000 = 13.287712379549449f;
constexpr int SMEM_BYTES = 54 * 1024 + 64;
#ifndef REP_D
#define REP_D 1
#endif
#ifndef REP_G
#define REP_G 1
#endif
#ifndef REP_H
#define REP_H 1
#endif

struct Params {
  const float *x, *c, *ctx, *c_ctx, *w_mod, *b_mod, *w_in, *qn, *kvn, *w_uq, *w_ukv, *lb_logits, *hg_norm,
      *diff_lambda, *diff_subln, *w_branch, *w_gate, *b_gate, *w_o, *ln1_g, *ln1_b, *w_ff1, *w_ff2, *ln2_g, *ln2_b;
  float* out;
  float *mod, *ctxres;
  bf16_t *win_t, *wuq_t, *wukv_t, *wg_t, *wb_t, *wo_t, *wff1_t, *wff2_t;
  bf16_t *h, *cbuf, *Qm, *Km, *Vtm, *hq, *zf, *zb, *gf, *gb, *hi, *hog, *dq, *dk, *dvt, *ymla, *yhg, *ydiff, *mbuf, *hid;
  float *hgst, *hgdec, *osum, *stash;
  unsigned* qctr;
  unsigned* xbar;
  unsigned* dep;
};

DI int tidx() {
  int t = threadIdx.x;
  asm volatile("" : "+v"(t));
  return t;
}
DI float bf2f(bf16_t v) { return __uint_as_float(((unsigned)v) << 16); }
DI unsigned pk2(float a, float b) {
  fv2 v = {a, b};
  bfv2 r = __builtin_convertvector(v, bfv2);
  return __builtin_bit_cast(unsigned, r);
}
DI bf16_t f2bf(float a) { return (bf16_t)(pk2(a, 0.f) & 0xffffu); }
DI int crow(int i, int hh) { return (i & 3) + 8 * (i >> 2) + 4 * hh; }
DI float silu_f(float x) { return x / (1.f + __expf(-x)); }
DI float sigmoid_f(float x) { return 1.f / (1.f + __expf(-x)); }
DI bf16x8 pack8(const f32x16& x, const int s) {
  u32x4 u;
  u.x = pk2(x[8 * s + 0], x[8 * s + 1]);
  u.y = pk2(x[8 * s + 2], x[8 * s + 3]);
  u.z = pk2(x[8 * s + 4], x[8 * s + 5]);
  u.w = pk2(x[8 * s + 6], x[8 * s + 7]);
  return __builtin_bit_cast(bf16x8, u);
}
DI float xor32_max(float v) {
  auto r = __builtin_amdgcn_permlane32_swap(__float_as_uint(v), __float_as_uint(v), false, false);
  return fmaxf(__uint_as_float(r[0]), __uint_as_float(r[1]));
}
DI bf16x8 cat4(bf16x4 lo, bf16x4 hi) { return __builtin_shufflevector(lo, hi, 0, 1, 2, 3, 4, 5, 6, 7); }
DI void zero16(f32x16& a) {
#pragma unroll
  for (int i = 0; i < 16; i++) a[i] = 0.f;
}

DI void patch_decode(int L, int mtiles, int ntiles, int& m, int& n) {
  const int per = 8 * ntiles;
  const int sr = L / per, q = L - sr * per;
  const int mc = min(8, mtiles - sr * 8);
  n = q / mc;
  m = sr * 8 + (q - n * mc);
}

DI const float* xsrc_row(const Params& p, int g, int layer, int row) {
  const int bl = row / LP, pp = row - bl * LP, b = g * GB + bl;
  if (pp < CTX) return (layer == 0 ? p.ctx : p.ctxres) + ((size_t)(b * CTX + pp)) * D;
  return (layer == 0 ? p.x : p.out) + ((size_t)b * SEQ + (pp - CTX)) * D;
}
DI float* xdst_row(const Params& p, int g, int row) {
  const int bl = row / LP, pp = row - bl * LP, b = g * GB + bl;
  if (pp < CTX) return p.ctxres + ((size_t)(b * CTX + pp)) * D;
  return p.out + ((size_t)b * SEQ + (pp - CTX)) * D;
}
DI const float* mod_row(const Params& p, int g, int layer, int row) {
  const int bl = row / LP, pp = row - bl * LP, b = g * GB + bl;
  return p.mod + ((size_t)(layer * 5 + (pp < CTX ? 4 : b))) * (6 * D);
}

template <int TN>
DI void gemm_core(const bf16_t* __restrict__ A, int lda, const bf16_t* __restrict__ Bt, int ldb, int K,
                  f32x16 (&acc)[2][TN], bf16_t* sA, bf16_t* sB) {
  const int tid = tidx(), lane = tid & 63, w = tid >> 6;
  const int wm = w >> 1, wn = w & 1, r = lane & 31, hh = lane >> 5;
  const int lrow = tid >> 3, lk = (tid & 7) * 8;
  constexpr int NB = 2 * TN;
  u32x4 ra0[4], rb0[NB], ra1[4], rb1[NB];
  const bf16_t* Ap = A + (size_t)lrow * lda + lk;
  const bf16_t* Bp = Bt + (size_t)lrow * ldb + lk;
  const int nk = K >> 6;
#pragma unroll
  for (int i = 0; i < 4; i++) ra0[i] = *(const u32x4*)(Ap + (size_t)(32 * i) * lda);
#pragma unroll
  for (int i = 0; i < NB; i++) rb0[i] = *(const u32x4*)(Bp + (size_t)(32 * i) * ldb);
#pragma unroll
  for (int i = 0; i < 4; i++) ra1[i] = *(const u32x4*)(Ap + 64 + (size_t)(32 * i) * lda);
#pragma unroll
  for (int i = 0; i < NB; i++) rb1[i] = *(const u32x4*)(Bp + 64 + (size_t)(32 * i) * ldb);
  auto compute = [&]() {
#pragma unroll
    for (int ks = 0; ks < 4; ks++) {
      bf16x8 af[2], bfr[TN];
#pragma unroll
      for (int mt = 0; mt < 2; mt++) af[mt] = *(const bf16x8*)(sA + (wm * 64 + mt * 32 + r) * 72 + ks * 16 + hh * 8);
#pragma unroll
      for (int nt = 0; nt < TN; nt++) bfr[nt] = *(const bf16x8*)(sB + (wn * 32 * TN + nt * 32 + r) * 72 + ks * 16 + hh * 8);
#pragma unroll
      for (int mt = 0; mt < 2; mt++)
#pragma unroll
        for (int nt = 0; nt < TN; nt++) acc[mt][nt] = MFMA(af[mt], bfr[nt], acc[mt][nt]);
    }
  };
  for (int kt = 0; kt < nk; kt += 2) {
    __syncthreads();
#pragma unroll
    for (int i = 0; i < 4; i++) *(u32x4*)(sA + (lrow + 32 * i) * 72 + lk) = ra0[i];
#pragma unroll
    for (int i = 0; i < NB; i++) *(u32x4*)(sB + (lrow + 32 * i) * 72 + lk) = rb0[i];
    __syncthreads();
    if (kt + 2 < nk) {
#pragma unroll
      for (int i = 0; i < 4; i++) ra0[i] = *(const u32x4*)(Ap + (kt + 2) * 64 + (size_t)(32 * i) * lda);
#pragma unroll
      for (int i = 0; i < NB; i++) rb0[i] = *(const u32x4*)(Bp + (kt + 2) * 64 + (size_t)(32 * i) * ldb);
    }
    __builtin_amdgcn_sched_barrier(0);
    compute();
    __syncthreads();
#pragma unroll
    for (int i = 0; i < 4; i++) *(u32x4*)(sA + (lrow + 32 * i) * 72 + lk) = ra1[i];
#pragma unroll
    for (int i = 0; i < NB; i++) *(u32x4*)(sB + (lrow + 32 * i) * 72 + lk) = rb1[i];
    __syncthreads();
    if (kt + 3 < nk) {
#pragma unroll
      for (int i = 0; i < 4; i++) ra1[i] = *(const u32x4*)(Ap + (kt + 3) * 64 + (size_t)(32 * i) * lda);
#pragma unroll
      for (int i = 0; i < NB; i++) rb1[i] = *(const u32x4*)(Bp + (kt + 3) * 64 + (size_t)(32 * i) * ldb);
    }
    __builtin_amdgcn_sched_barrier(0);
    compute();
  }
}

DI void gemm_core1(const bf16_t* __restrict__ A, int lda, const bf16_t* __restrict__ Bt, int ldb, int K,
                   f32x16 (&acc)[2][2], bf16_t* sA, bf16_t* sB) {
  const int tid = tidx(), lane = tid & 63, w = tid >> 6;
  const int wm = w >> 1, wn = w & 1, r = lane & 31, hh = lane >> 5;
  const int lrow = tid >> 3, lk = (tid & 7) * 8;
  u32x4 ra[4], rb[4];
  const bf16_t* Ap = A + (size_t)lrow * lda + lk;
  const bf16_t* Bp = Bt + (size_t)lrow * ldb + lk;
#pragma unroll
  for (int i = 0; i < 4; i++) ra[i] = *(const u32x4*)(Ap + (size_t)(32 * i) * lda);
#pragma unroll
  for (int i = 0; i < 4; i++) rb[i] = *(const u32x4*)(Bp + (size_t)(32 * i) * ldb);
  const int nk = K >> 6;
  for (int kt = 0; kt < nk; kt++) {
    __syncthreads();
#pragma unroll
    for (int i = 0; i < 4; i++) *(u32x4*)(sA + (lrow + 32 * i) * 72 + lk) = ra[i];
#pragma unroll
    for (int i = 0; i < 4; i++) *(u32x4*)(sB + (lrow + 32 * i) * 72 + lk) = rb[i];
    __syncthreads();
    if (kt + 1 < nk) {
      Ap += 64;
      Bp += 64;
#pragma unroll
      for (int i = 0; i < 4; i++) ra[i] = *(const u32x4*)(Ap + (size_t)(32 * i) * lda);
#pragma unroll
      for (int i = 0; i < 4; i++) rb[i] = *(const u32x4*)(Bp + (size_t)(32 * i) * ldb);
    }
    __builtin_amdgcn_sched_barrier(0);
#pragma unroll
    for (int ks = 0; ks < 4; ks++) {
      bf16x8 af[2], bfr[2];
#pragma unroll
      for (int mt = 0; mt < 2; mt++) af[mt] = *(const bf16x8*)(sA + (wm * 64 + mt * 32 + r) * 72 + ks * 16 + hh * 8);
#pragma unroll
      for (int nt = 0; nt < 2; nt++) bfr[nt] = *(const bf16x8*)(sB + (wn * 64 + nt * 32 + r) * 72 + ks * 16 + hh * 8);
#pragma unroll
      for (int mt = 0; mt < 2; mt++)
#pragma unroll
        for (int nt = 0; nt < 2; nt++) acc[mt][nt] = MFMA(af[mt], bfr[nt], acc[mt][nt]);
    }
  }
}

DI void gemm_core_wide(const bf16_t* __restrict__ A, int lda, const bf16_t* __restrict__ Bt, int ldb, int K,
                       f32x16 (&acc)[2][4], bf16_t* sA, bf16_t* sB) {
  const int tid = tidx(), lane = tid & 63, w = tid >> 6;
  const int wm = w >> 1, wn = w & 1, r = lane & 31, hh = lane >> 5;
  const int lrow = tid >> 3, lk = (tid & 7) * 8;
  u32x4 ra[4], rb[8];
  const bf16_t* Ap = A + (size_t)lrow * lda + lk;
  const bf16_t* Bp = Bt + (size_t)lrow * ldb + lk;
#pragma unroll
  for (int i = 0; i < 4; i++) ra[i] = *(const u32x4*)(Ap + (size_t)(32 * i) * lda);
#pragma unroll
  for (int i = 0; i < 8; i++) rb[i] = *(const u32x4*)(Bp + (size_t)(32 * i) * ldb);
  const int nk = K >> 6;
  for (int kt = 0; kt < nk; kt++) {
    __syncthreads();
#pragma unroll
    for (int i = 0; i < 4; i++) *(u32x4*)(sA + (lrow + 32 * i) * 72 + lk) = ra[i];
#pragma unroll
    for (int i = 0; i < 8; i++) *(u32x4*)(sB + (lrow + 32 * i) * 72 + lk) = rb[i];
    __syncthreads();
    if (kt + 1 < nk) {
      Ap += 64;
      Bp += 64;
#pragma unroll
      for (int i = 0; i < 4; i++) ra[i] = *(const u32x4*)(Ap + (size_t)(32 * i) * lda);
#pragma unroll
      for (int i = 0; i < 8; i++) rb[i] = *(const u32x4*)(Bp + (size_t)(32 * i) * ldb);
    }
    __builtin_amdgcn_sched_barrier(0);
#pragma unroll
    for (int ks = 0; ks < 4; ks++) {
      bf16x8 af[2], bfr[4];
#pragma unroll
      for (int mt = 0; mt < 2; mt++) af[mt] = *(const bf16x8*)(sA + (wm * 64 + mt * 32 + r) * 72 + ks * 16 + hh * 8);
#pragma unroll
      for (int nt = 0; nt < 4; nt++) bfr[nt] = *(const bf16x8*)(sB + (wn * 128 + nt * 32 + r) * 72 + ks * 16 + hh * 8);
#pragma unroll
      for (int mt = 0; mt < 2; mt++)
#pragma unroll
        for (int nt = 0; nt < 4; nt++) acc[mt][nt] = MFMA(af[mt], bfr[nt], acc[mt][nt]);
    }
  }
}

DI int map_col(int maptype, int n) {
  if (maptype == 1) return n < 416 ? 4096 + n : n - 416;
  if (maptype == 2) {
    const int up = n >= FFH ? 1 : 0;
    const int j = n - up * FFH;
    return (j >> 7) * 256 + ((j >> 6) & 1) * 128 + ((j >> 5) & 1) * 64 + up * 32 + (j & 31);
  }
  return n;
}
DI void conv_tile(const float* __restrict__ src, int K, int N, int k0, int n0, bf16_t* __restrict__ dst, int maptype,
                  const float* __restrict__ rowscale, float* sT) {
  const int tid = tidx();
  __syncthreads();
#pragma unroll
  for (int i = 0; i < 4; i++) {
    const int kk = (tid >> 4) + 16 * i, nl = (tid & 15) * 4, n = n0 + nl;
    float4 v = make_float4(0.f, 0.f, 0.f, 0.f);
    if (n < N) v = *(const float4*)(src + (size_t)(k0 + kk) * N + n);
    const float sc = rowscale ? rowscale[k0 + kk] : 1.f;
    sT[kk * 65 + nl + 0] = v.x * sc;
    sT[kk * 65 + nl + 1] = v.y * sc;
    sT[kk * 65 + nl + 2] = v.z * sc;
    sT[kk * 65 + nl + 3] = v.w * sc;
  }
  __syncthreads();
#pragma unroll
  for (int i = 0; i < 2; i++) {
    const int nl = (tid >> 3) + 32 * i, k8 = (tid & 7) * 8, n = n0 + nl;
    if (n < N) {
      u32x4 u;
      u.x = pk2(sT[(k8 + 0) * 65 + nl], sT[(k8 + 1) * 65 + nl]);
      u.y = pk2(sT[(k8 + 2) * 65 + nl], sT[(k8 + 3) * 65 + nl]);
      u.z = pk2(sT[(k8 + 4) * 65 + nl], sT[(k8 + 5) * 65 + nl]);
      u.w = pk2(sT[(k8 + 6) * 65 + nl], sT[(k8 + 7) * 65 + nl]);
      *(u32x4*)(dst + (size_t)map_col(maptype, n) * K + k0 + k8) = u;
    }
  }
}
constexpr int CV_IN = 16 * 71, CV_G = 3 * 256, CV_B = 3 * 8 * 16, CV_O = 256, CV_F1 = 16 * 88, CV_F2 = 44 * 16,
              CV_UQ = 4 * 12, CV_UKV = 2 * 16;
constexpr int CV_TOTAL = CV_IN + CV_G + CV_B + CV_O + CV_F1 + CV_F2 + CV_UQ + CV_UKV + 1;
DI void conv_item(const Params& p, int layer, int it, char* smem) {
  float* sT = (float*)smem;
  if (it < CV_IN) {
    conv_tile(p.w_in + (size_t)layer * D * INW, D, INW, (it / 71) * 64, (it % 71) * 64, p.win_t, 1, nullptr, sT);
    return;
  }
  it -= CV_IN;
  if (it < CV_G) {
    const int i = it >> 8, t = it & 255;
    conv_tile(p.w_gate + ((size_t)layer * 3 + i) * D * D, D, D, (t >> 4) * 64, (t & 15) * 64, p.wg_t + (size_t)i * D * D, 0, nullptr, sT);
    return;
  }
  it -= CV_G;
  if (it < CV_B) {
    const int i = it >> 7, t = it & 127;
    conv_tile(p.w_branch + ((size_t)layer * 3 + i) * 512 * D, 512, D, (t >> 4) * 64, (t & 15) * 64, p.wb_t + (size_t)i * D * 512, 0, nullptr, sT);
    return;
  }
  it -= CV_B;
  if (it < CV_O) {
    conv_tile(p.w_o + (size_t)layer * D * D, D, D, (it >> 4) * 64, (it & 15) * 64, p.wo_t, 0, nullptr, sT);
    return;
  }
  it -= CV_O;
  if (it < CV_F1) {
    conv_tile(p.w_ff1 + (size_t)layer * D * 2 * FFH, D, 2 * FFH, (it / 88) * 64, (it % 88) * 64, p.wff1_t, 2, nullptr, sT);
    return;
  }
  it -= CV_F1;
  if (it < CV_F2) {
    conv_tile(p.w_ff2 + (size_t)layer * FFH * D, FFH, D, (it >> 4) * 64, (it & 15) * 64, p.wff2_t, 0, nullptr, sT);
    return;
  }
  it -= CV_F2;
  if (it < CV_UQ) {
    conv_tile(p.w_uq + (size_t)layer * 256 * 768, 256, 768, (it / 12) * 64, (it % 12) * 64, p.wuq_t, 0, p.qn + layer * 256, sT);
    return;
  }
  it -= CV_UQ;
  if (it < CV_UKV) {
    conv_tile(p.w_ukv + (size_t)layer * 128 * 1024, 128, 1024, (it >> 4) * 64, (it & 15) * 64, p.wukv_t, 0, p.kvn + layer * 128, sT);
    return;
  }
  u32x4 z = u32x4{0u, 0u, 0u, 0u};
  for (int e = tidx(); e < 96 * D / 8; e += 256) *(u32x4*)(p.win_t + (size_t)INW * D + (size_t)e * 8) = z;
}

DI void mod_item(const Params& p, int it, char* smem) {
  float* sC = (float*)smem;
  float* sR = sC + 5 * D;
  const int layer = it / 96, cb = it % 96;
  __syncthreads();
  for (int e = tidx(); e < 5 * D; e += 256) {
    const float v = e < 4 * D ? p.c[e] : p.c_ctx[e - 4 * D];
    sC[e] = silu_f(v);
  }
  __syncthreads();
  const int tid = tidx(), cl = tid & 63, kp = tid >> 6;
  const int n = cb * 64 + cl;
  const float* W = p.w_mod + (size_t)layer * D * 6 * D + (size_t)(kp * 256) * 6 * D + n;
  const float* cc = sC + kp * 256;
  float a0 = 0.f, a1 = 0.f, a2 = 0.f, a3 = 0.f, a4 = 0.f;
#pragma unroll 8
  for (int k = 0; k < 256; k++) {
    const float wv = W[(size_t)k * 6 * D];
    a0 += cc[k] * wv;
    a1 += cc[D + k] * wv;
    a2 += cc[2 * D + k] * wv;
    a3 += cc[3 * D + k] * wv;
    a4 += cc[4 * D + k] * wv;
  }
  sR[(kp * 5 + 0) * 64 + cl] = a0;
  sR[(kp * 5 + 1) * 64 + cl] = a1;
  sR[(kp * 5 + 2) * 64 + cl] = a2;
  sR[(kp * 5 + 3) * 64 + cl] = a3;
  sR[(kp * 5 + 4) * 64 + cl] = a4;
  __syncthreads();
  if (tid < 64) {
    const float bb = p.b_mod[layer * 6 * D + n];
    float* o = p.mod + (size_t)layer * 5 * 6 * D + n;
#pragma unroll
    for (int r = 0; r < 5; r++)
      o[(size_t)r * 6 * D] = sR[(0 * 5 + r) * 64 + tid] + sR[(1 * 5 + r) * 64 + tid] + sR[(2 * 5 + r) * 64 + tid] + sR[(3 * 5 + r) * 64 + tid] + bb;
  }
}

DI void rowpass_rows(const Params& p, bf16_t* hb, int g, int r0, int r1, int mode, int src_layer, const float* lng, const float* lnb,
                     int mod_layer, int mod_off, bool need_h) {
  const int lane = tidx() & 63, w = tidx() >> 6;
  float4 v[4], nv[4];
  if (r0 + w < r1) {
    const float* src0 = xsrc_row(p, g, src_layer, r0 + w);
#pragma unroll
    for (int j = 0; j < 4; j++) nv[j] = *(const float4*)(src0 + lane * 4 + 256 * j);
  }
#pragma unroll 1
  for (int row = r0 + w; row < r1; row += 4) {
#pragma unroll
    for (int j = 0; j < 4; j++) v[j] = nv[j];
    if (row + 4 < r1) {
      const float* srcn = xsrc_row(p, g, src_layer, row + 4);
#pragma unroll
      for (int j = 0; j < 4; j++) nv[j] = *(const float4*)(srcn + lane * 4 + 256 * j);
    }
    if (mode == 1) {
      float s = 0.f;
#pragma unroll
      for (int j = 0; j < 4; j++) s += v[j].x + v[j].y + v[j].z + v[j].w;
#pragma unroll
      for (int o = 32; o >= 1; o >>= 1) s += __shfl_xor(s, o);
      const float mu = s * (1.f / D);
      float q = 0.f;
#pragma unroll
      for (int j = 0; j < 4; j++) {
        v[j].x -= mu; v[j].y -= mu; v[j].z -= mu; v[j].w -= mu;
        q += v[j].x * v[j].x + v[j].y * v[j].y + v[j].z * v[j].z + v[j].w * v[j].w;
      }
#pragma unroll
      for (int o = 32; o >= 1; o >>= 1) q += __shfl_xor(q, o);
      const float rstd = rsqrtf(q * (1.f / D) + 1e-5f);
      float* dst = xdst_row(p, g, row);
#pragma unroll
      for (int j = 0; j < 4; j++) {
        const float4 gg = *(const float4*)(lng + lane * 4 + 256 * j);
        const float4 bb = *(const float4*)(lnb + lane * 4 + 256 * j);
        v[j].x = v[j].x * rstd * gg.x + bb.x;
        v[j].y = v[j].y * rstd * gg.y + bb.y;
        v[j].z = v[j].z * rstd * gg.z + bb.z;
        v[j].w = v[j].w * rstd * gg.w + bb.w;
        *(float4*)(dst + lane * 4 + 256 * j) = v[j];
      }
    }
    if (need_h) {
      const float* md = mod_row(p, g, mod_layer, row) + mod_off;
#pragma unroll
      for (int j = 0; j < 4; j++) {
        const float4 sh = *(const float4*)(md + lane * 4 + 256 * j);
        const float4 sc = *(const float4*)(md + D + lane * 4 + 256 * j);
        u32x2 u;
        u.x = pk2(v[j].x * (1.f + sc.x) + sh.x, v[j].y * (1.f + sc.y) + sh.y);
        u.y = pk2(v[j].z * (1.f + sc.z) + sh.z, v[j].w * (1.f + sc.w) + sh.w);
        *(u32x2*)(hb + (size_t)row * D + lane * 4 + 256 * j) = u;
      }
    }
  }
}

DI float hg_lower_bound(const Params& p, int dir, int layer, int col);
DI void inproj_item(const Params& p, const bf16_t* hb, int layer, int it, char* smem) {
  bf16_t* sA = (bf16_t*)smem;
  bf16_t* sB = sA + 128 * 72;
  int mti, nti;
  patch_decode(it, MT, 36, mti, nti);
  const int m0 = mti * 128, n0 = nti * 128;
  f32x16 acc[2][2];
#pragma unroll
  for (int a = 0; a < 2; a++)
#pragma unroll
    for (int b = 0; b < 2; b++) zero16(acc[a][b]);
  gemm_core<2>(hb + (size_t)m0 * D, D, p.win_t + (size_t)n0 * D, D, D, acc, sA, sB);
  const int lane = tidx() & 63, w = tidx() >> 6, wm = w >> 1, wn = w & 1, r = lane & 31, hh = lane >> 5;
  const int bl = m0 / LP, pb = m0 - bl * LP;
  const bool isctx = pb < CTX;
  const int seg = n0 >> 9;
  const int cw = n0 + wn * 64;
  const int rowb = m0 + wm * 64;
  if (seg == 1 || seg == 2) {
    bf16_t* dk_ = seg == 1 ? p.zf : p.zb;
    bf16_t* dg_ = seg == 1 ? p.gf : p.gb;
    const int cc = cw - seg * 512;
#pragma unroll
    for (int nt = 0; nt < 2; nt++) {
      const int col = cc + nt * 32 + r;
      const float lb = hg_lower_bound(p, seg - 1, layer, col);
#pragma unroll
      for (int mt = 0; mt < 2; mt++)
#pragma unroll
        for (int i = 0; i < 16; i++) {
          const int row = rowb + mt * 32 + crow(i, hh);
          const float z = acc[mt][nt][i];
          const float ez = __expf(-fabsf(z));
          const float ls = fminf(z, 0.f) - __logf(1.f + ez);
          const float lf = lb > 0.f ? __logf(lb + (1.f - lb) * __expf(ls)) : ls;
          const float kv = (1.f - lb) * __expf(ls - z);
          dk_[(size_t)row * 512 + col] = f2bf(kv);
          dg_[(size_t)row * 512 + col] = f2bf(lf);
        }
    }
  } else if (seg <= 4) {
    bf16_t* dst = seg == 0 ? p.hq : seg == 3 ? p.hi : p.hog;
    const int cc = cw - seg * 512;
#pragma unroll
    for (int mt = 0; mt < 2; mt++)
#pragma unroll
      for (int nt = 0; nt < 2; nt++)
#pragma unroll
        for (int i = 0; i < 16; i++) {
          const int row = rowb + mt * 32 + crow(i, hh);
          float v = acc[mt][nt][i];
          if (seg == 0) v = silu_f(v) * HG_SCALE;
          dst[(size_t)row * 512 + cc + nt * 32 + r] = f2bf(v);
        }
  } else if (seg <= 6) {
    const int cc = cw - seg * 512;
    const int hd = cc >> 7, half = (cc >> 6) & 1;
    bf16_t* dst = (seg == 5 ? p.dq : p.dk) + ((size_t)((bl * 4 + hd) * 2 + half) * LP) * 64;
    const float sc = seg == 5 ? DIFF_QSCALE : 1.f;
    const float invf = exp2f(-(float)(r & 15) * (LOG2_10000 / 16.f));
#pragma unroll
    for (int mt = 0; mt < 2; mt++)
#pragma unroll
      for (int i = 0; i < 16; i++) {
        const int pp = rowb + mt * 32 + crow(i, hh) - bl * LP;
        float x1 = acc[mt][0][i], x2 = acc[mt][1][i];
        if (!isctx) {
          const int t = pp - CTX;
          const float pos = (float)(r < 16 ? (t >> 6) : (t & 63));
          const float ang = pos * invf;
          const float cs = __cosf(ang), sn = __sinf(ang);
          const float o1 = x1 * cs - x2 * sn, o2 = x1 * sn + x2 * cs;
          x1 = o1;
          x2 = o2;
        }
        dst[(size_t)pp * 64 + r] = f2bf(x1 * sc);
        dst[(size_t)pp * 64 + 32 + r] = f2bf(x2 * sc);
      }
  } else if (seg == 7) {
    const int cc = cw - 3584;
    const int hd = cc >> 7, dvb = cc & 127;
    bf16_t* dst = p.dvt + ((size_t)(bl * 4 + hd) * 128) * LP;
#pragma unroll
    for (int mt = 0; mt < 2; mt++)
#pragma unroll
      for (int nt = 0; nt < 2; nt++)
#pragma unroll
        for (int gq = 0; gq < 4; gq++) {
          const int pp0 = rowb + mt * 32 + 8 * gq + 4 * hh - bl * LP;
          u32x2 u;
          u.x = pk2(acc[mt][nt][4 * gq + 0], acc[mt][nt][4 * gq + 1]);
          u.y = pk2(acc[mt][nt][4 * gq + 2], acc[mt][nt][4 * gq + 3]);
          *(u32x2*)(dst + (size_t)(dvb + nt * 32 + r) * LP + pp0) = u;
        }
  } else {
    const int cc = cw - 4096;
#pragma unroll
    for (int mt = 0; mt < 2; mt++)
#pragma unroll
      for (int nt = 0; nt < 2; nt++) {
        const int col = cc + nt * 32 + r;
        if (col < 416) {
#pragma unroll
          for (int i = 0; i < 16; i++) {
            const int row = rowb + mt * 32 + crow(i, hh);
            p.cbuf[(size_t)row * 416 + col] = f2bf(acc[mt][nt][i]);
          }
        }
      }
  }
}

DI void upq_item(const Params& p, int it, char* smem) {
  bf16_t* sA = (bf16_t*)smem;
  bf16_t* sB = sA + 128 * 72;
  float* sRS = (float*)(smem + 2 * 128 * 72 * 2);
  int mti, nti;
  patch_decode(it, MT, 6, mti, nti);
  const int m0 = mti * 128, n0 = nti * 128;
  const int tid = tidx();
  __syncthreads();
  {
    const int row = tid >> 1, part = tid & 1;
    const bf16_t* src = p.cbuf + (size_t)(m0 + row) * 416 + part * 128;
    float ss = 0.f;
#pragma unroll
    for (int j = 0; j < 16; j++) {
      const u32x4 u = *(const u32x4*)(src + j * 8);
      const unsigned uu[4] = {u.x, u.y, u.z, u.w};
#pragma unroll
      for (int q = 0; q < 4; q++) {
        const float a = __uint_as_float(uu[q] << 16), b = __uint_as_float(uu[q] & 0xffff0000u);
        ss += a * a + b * b;
      }
    }
    ss += __shfl_xor(ss, 1);
    if (part == 0) sRS[row] = rsqrtf(ss * (1.f / 256.f) + 1e-6f);
  }
  f32x16 acc[2][2];
#pragma unroll
  for (int a = 0; a < 2; a++)
#pragma unroll
    for (int b = 0; b < 2; b++) zero16(acc[a][b]);
  gemm_core<2>(p.cbuf + (size_t)m0 * 416, 416, p.wuq_t + (size_t)n0 * 256, 256, 256, acc, sA, sB);
  const int lane = tid & 63, w = tid >> 6, wm = w >> 1, wn = w & 1, r = lane & 31, hh = lane >> 5;
  const int bl = m0 / LP, pb = m0 - bl * LP;
  const bool isctx = pb < CTX;
  const float invf = exp2f(-(float)(r & 7) * (LOG2_10000 / 8.f));
#pragma unroll
  for (int mt = 0; mt < 2; mt++)
#pragma unroll
    for (int nt = 0; nt < 2; nt++) {
      const int nb = n0 + wn * 64 + nt * 32;
      const int hd = nb / 96, d0 = nb - hd * 96;
      const bool ispe = (d0 == 64) && !isctx;
      bf16_t* dst = p.Qm + ((size_t)(bl * 8 + hd) * LP) * 96 + d0 + r;
#pragma unroll
      for (int i = 0; i < 16; i++) {
        const int rl = wm * 64 + mt * 32 + crow(i, hh);
        const int pp = pb + rl;
        float v = acc[mt][nt][i] * sRS[rl];
        if (ispe) {
          const float pv = __shfl_xor(v, 16);
          const int t = pp - CTX;
          const float pos = (float)((r & 15) < 8 ? (t >> 6) : (t & 63));
          const float ang = pos * invf;
          const float cs = __cosf(ang), sn = __sinf(ang);
          v = (r < 16) ? (v * cs - pv * sn) : (pv * sn + v * cs);
        }
        dst[(size_t)pp * 96] = f2bf(v * MLA_QSCALE);
      }
    }
}
DI void upkv_item(const Params& p, int it, char* smem) {
  bf16_t* sA = (bf16_t*)smem;
  bf16_t* sB = sA + 128 * 72;
  float* sRS = (float*)(smem + 2 * 128 * 72 * 2);
  int mti, hd;
  patch_decode(it, MT, 8, mti, hd);
  const int m0 = mti * 128, n0 = hd * 128;
  const int tid = tidx();
  __syncthreads();
  {
    const int row = tid >> 1, part = tid & 1;
    const bf16_t* src = p.cbuf + (size_t)(m0 + row) * 416 + 256 + part * 64;
    float ss = 0.f;
#pragma unroll
    for (int j = 0; j < 8; j++) {
      const u32x4 u = *(const u32x4*)(src + j * 8);
      const unsigned uu[4] = {u.x, u.y, u.z, u.w};
#pragma unroll
      for (int q = 0; q < 4; q++) {
        const float a = __uint_as_float(uu[q] << 16), b = __uint_as_float(uu[q] & 0xffff0000u);
        ss += a * a + b * b;
      }
    }
    ss += __shfl_xor(ss, 1);
    if (part == 0) sRS[row] = rsqrtf(ss * (1.f / 128.f) + 1e-6f);
  }
  f32x16 acc[2][2];
#pragma unroll
  for (int a = 0; a < 2; a++)
#pragma unroll
    for (int b = 0; b < 2; b++) zero16(acc[a][b]);
  gemm_core<2>(p.cbuf + (size_t)m0 * 416 + 256, 416, p.wukv_t + (size_t)n0 * 128, 128, 128, acc, sA, sB);
  const int lane = tid & 63, w = tid >> 6, wm = w >> 1, wn = w & 1, r = lane & 31, hh = lane >> 5;
  const int bl = m0 / LP, pb = m0 - bl * LP;
  if (wn == 0) {
    bf16_t* dst = p.Km + ((size_t)(bl * 8 + hd) * LP) * 96;
#pragma unroll
    for (int mt = 0; mt < 2; mt++)
#pragma unroll
      for (int nt = 0; nt < 2; nt++)
#pragma unroll
        for (int i = 0; i < 16; i++) {
          const int rl = wm * 64 + mt * 32 + crow(i, hh);
          dst[(size_t)(pb + rl) * 96 + nt * 32 + r] = f2bf(acc[mt][nt][i] * sRS[rl]);
        }
  } else {
    bf16_t* dst = p.Vtm + ((size_t)(bl * 8 + hd) * 64) * LP;
#pragma unroll
    for (int mt = 0; mt < 2; mt++)
#pragma unroll
      for (int nt = 0; nt < 2; nt++)
#pragma unroll
        for (int gq = 0; gq < 4; gq++) {
          const int rl = wm * 64 + mt * 32 + 8 * gq + 4 * hh;
          u32x2 u;
          u.x = pk2(acc[mt][nt][4 * gq + 0] * sRS[rl + 0], acc[mt][nt][4 * gq + 1] * sRS[rl + 1]);
          u.y = pk2(acc[mt][nt][4 * gq + 2] * sRS[rl + 2], acc[mt][nt][4 * gq + 3] * sRS[rl + 3]);
          *(u32x2*)(dst + (size_t)(nt * 32 + r) * LP + pb + rl) = u;
        }
  }
}
DI void kpe_item(const Params& p, int it) {
  const int m0 = it * 128;
  const int tid = tidx(), row = m0 + (tid >> 1), part = tid & 1;
  const int bl = m0 / LP, pp = row - bl * LP;
  const bool isctx = pp < CTX;
  const bf16_t* src = p.cbuf + (size_t)row * 416 + 384;
#pragma unroll
  for (int jj = 0; jj < 8; jj++) {
    const int j = part * 8 + jj;
    float x1 = bf2f(src[j]), x2 = bf2f(src[j + 16]);
    if (!isctx) {
      const int t = pp - CTX;
      const float invf = exp2f(-(float)(j & 7) * (LOG2_10000 / 8.f));
      const float pos = (float)(j < 8 ? (t >> 6) : (t & 63));
      const float ang = pos * invf;
      const float cs = __cosf(ang), sn = __sinf(ang);
      const float o1 = x1 * cs - x2 * sn, o2 = x1 * sn + x2 * cs;
      x1 = o1;
      x2 = o2;
    }
    const bf16_t b1 = f2bf(x1), b2 = f2bf(x2);
#pragma unroll
    for (int hd = 0; hd < 8; hd++) {
      bf16_t* dst = p.Km + ((size_t)(bl * 8 + hd) * LP + pp) * 96 + 64;
      dst[j] = b1;
      dst[j + 16] = b2;
    }
  }
}

template <int DQK, int DV>
DI void flash_core(const bf16_t* __restrict__ Q, const bf16_t* __restrict__ Kb, const bf16_t* __restrict__ Vt, int nkt,
                   f32x16 (&O)[DV / 32], float& lsum_out, char* smem) {
  constexpr int KS = DQK + 8;
  constexpr int VS = 68;
  constexpr int KCH = 64 * DQK / 8 / 256;
  constexpr int VCH = DV * 8 / 256;
  constexpr int BUF = 64 * KS + DV * VS;
  constexpr int CPR = DQK / 8;
  bf16_t* sbase = (bf16_t*)smem;
  const int tid = tidx(), lane = tid & 63, w = tid >> 6, r = lane & 31, hh = lane >> 5;
  bf16x8 qf[DQK / 16];
  {
    const bf16_t* qp = Q + (size_t)(w * 32 + r) * DQK + hh * 8;
#pragma unroll
    for (int ks = 0; ks < DQK / 16; ks++) qf[ks] = *(const bf16x8*)(qp + ks * 16);
  }
#pragma unroll
  for (int d = 0; d < DV / 32; d++) zero16(O[d]);
  float m_run = 0.f, l_run = 0.f;
  constexpr bool NEGM = (DV <= 64);
  f32x16 negm;
  zero16(negm);
  u32x4 rk[KCH], rv[VCH];
  auto gload = [&](int kt) {
#pragma unroll
    for (int i = 0; i < KCH; i++) rk[i] = *(const u32x4*)(Kb + (size_t)kt * 64 * DQK + (size_t)(tid + 256 * i) * 8);
#pragma unroll
    for (int i = 0; i < VCH; i++) {
      const int c = tid + 256 * i;
      rv[i] = *(const u32x4*)(Vt + (size_t)(c >> 3) * LP + kt * 64 + (c & 7) * 8);
    }
  };
  auto sstore = [&](int buf) {
    bf16_t* sK = sbase + buf * BUF;
    bf16_t* sV = sK + 64 * KS;
#pragma unroll
    for (int i = 0; i < KCH; i++) {
      const int c = tid + 256 * i;
      *(u32x4*)(sK + (c / CPR) * KS + (c % CPR) * 8) = rk[i];
    }
#pragma unroll
    for (int i = 0; i < VCH; i++) {
      const int c = tid + 256 * i;
      bf16_t* d = sV + (c >> 3) * VS + (c & 7) * 8;
      *(u32x2*)(d) = u32x2{rv[i].x, rv[i].y};
      *(u32x2*)(d + 4) = u32x2{rv[i].z, rv[i].w};
    }
  };
  __syncthreads();
  gload(0);
  sstore(0);
  __syncthreads();
  for (int kt = 0; kt < nkt; kt++) {
    const int buf = kt & 1;
    if (kt + 1 < nkt) gload(kt + 1);
    const bf16_t* sK = sbase + buf * BUF;
    const bf16_t* sV = sK + 64 * KS;
    constexpr int NKS = DQK / 16, ND = DV / 32;
    f32x16 S[2];
    {
      bf16x8 kf[2][NKS];
#pragma unroll
      for (int kb = 0; kb < 2; kb++)
#pragma unroll
        for (int ks = 0; ks < NKS; ks++) kf[kb][ks] = *(const bf16x8*)(sK + (kb * 32 + r) * KS + ks * 16 + hh * 8);
      if (NEGM) {
        S[0] = MFMA(kf[0][0], qf[0], negm);
        S[1] = MFMA(kf[1][0], qf[0], negm);
      } else {
        zero16(S[0]);
        zero16(S[1]);
        S[0] = MFMA(kf[0][0], qf[0], S[0]);
        S[1] = MFMA(kf[1][0], qf[0], S[1]);
      }
#pragma unroll
      for (int ks = 1; ks < NKS; ks++) {
        S[0] = MFMA(kf[0][ks], qf[ks], S[0]);
        S[1] = MFMA(kf[1][ks], qf[ks], S[1]);
      }
    }
    bf16x8 vfa[ND], vfb[ND];
#pragma unroll
    for (int d = 0; d < ND; d++) {
      const bf16_t* vp = sV + (d * 32 + r) * VS + 4 * hh;
      vfa[d] = cat4(*(const bf16x4*)vp, *(const bf16x4*)(vp + 8));
    }
    float mx = S[0][0];
#pragma unroll
    for (int i = 1; i < 16; i++) mx = fmaxf(mx, S[0][i]);
#pragma unroll
    for (int i = 0; i < 16; i++) mx = fmaxf(mx, S[1][i]);
    mx = xor32_max(mx);
    if (NEGM) {
      if (kt == 0 || __builtin_amdgcn_ballot_w64(mx > 8.f) != 0) {
        const float delta = kt == 0 ? mx : fmaxf(mx, 0.f);
        const float alpha = __builtin_amdgcn_exp2f(-delta);
        m_run += delta;
        l_run *= alpha;
#pragma unroll
        for (int d = 0; d < ND; d++)
#pragma unroll
          for (int i = 0; i < 16; i++) O[d][i] *= alpha;
#pragma unroll
        for (int i = 0; i < 16; i++) {
          negm[i] = -m_run;
          S[0][i] -= delta;
          S[1][i] -= delta;
        }
      }
    } else {
      if (kt == 0 || __builtin_amdgcn_ballot_w64(mx > m_run + 8.f) != 0) {
        const float m_new = kt == 0 ? mx : fmaxf(m_run, mx);
        const float alpha = __builtin_amdgcn_exp2f(m_run - m_new);
        m_run = m_new;
        l_run *= alpha;
#pragma unroll
        for (int d = 0; d < ND; d++)
#pragma unroll
          for (int i = 0; i < 16; i++) O[d][i] *= alpha;
      }
    }
    float ls = 0.f;
#pragma unroll
    for (int kb = 0; kb < 2; kb++)
#pragma unroll
      for (int i = 0; i < 16; i++) {
        const float pv = __builtin_amdgcn_exp2f(NEGM ? S[kb][i] : S[kb][i] - m_run);
        S[kb][i] = pv;
        ls += pv;
      }
    l_run += ls;
    bf16x8 pf[2][2];
#pragma unroll
    for (int kb = 0; kb < 2; kb++)
#pragma unroll
      for (int s = 0; s < 2; s++) pf[kb][s] = pack8(S[kb], s);
#pragma unroll
    for (int gi = 0; gi < 4; gi++) {
      const int kb = gi >> 1, sx = gi & 1;
      if (gi + 1 < 4) {
        const int kb2 = (gi + 1) >> 1, s2 = (gi + 1) & 1;
#pragma unroll
        for (int d = 0; d < ND; d++) {
          const bf16_t* vp = sV + (d * 32 + r) * VS + kb2 * 32 + 16 * s2 + 4 * hh;
          const bf16x8 t = cat4(*(const bf16x4*)vp, *(const bf16x4*)(vp + 8));
          if (gi & 1) vfa[d] = t; else vfb[d] = t;
        }
      }
#pragma unroll
      for (int d = 0; d < ND; d++) O[d] = MFMA((gi & 1) ? vfb[d] : vfa[d], pf[kb][sx], O[d]);
      }
    if (kt + 1 < nkt) sstore(buf ^ 1);
    __syncthreads();
  }
  lsum_out = l_run + __shfl_xor(l_run, 32);
}

DI void mla_item(const Params& p, int hb, int qt, char* smem) {
  const int bl = hb >> 3, hd = hb & 7;
  const int nkt = qt < 2 ? CTX / 64 : LP / 64;
  f32x16 O[2];
  float l;
  flash_core<96, 64>(p.Qm + ((size_t)hb * LP + qt * 128) * 96, p.Km + (size_t)hb * LP * 96, p.Vtm + (size_t)hb * 64 * LP, nkt, O, l, smem);
  const int lane = tidx() & 63, w = tidx() >> 6, r = lane & 31, hh = lane >> 5;
  const float inv = 1.f / l;
  bf16_t* dst = p.ymla + ((size_t)(bl * LP + qt * 128 + w * 32 + r)) * 512 + hd * 64;
#pragma unroll
  for (int d = 0; d < 2; d++)
#pragma unroll
    for (int gq = 0; gq < 4; gq++) {
      u32x2 u;
      u.x = pk2(O[d][4 * gq + 0] * inv, O[d][4 * gq + 1] * inv);
      u.y = pk2(O[d][4 * gq + 2] * inv, O[d][4 * gq + 3] * inv);
      *(u32x2*)(dst + d * 32 + 8 * gq + 4 * hh) = u;
    }
}

DI void diff_item(const Params& p, int layer, float lam_init, int hb, int qt, char* smem) {
  const int bl = hb >> 2, hd = hb & 3;
  const int nkt = qt < 2 ? CTX / 64 : LP / 64;
  const int tid = tidx(), lane = tid & 63, w = tid >> 6, r = lane & 31, hh = lane >> 5;
  const float* dl = p.diff_lambda + layer * 256;
  float s1 = 0.f, s2 = 0.f;
  for (int j = 0; j < 64; j++) {
    s1 += dl[j] * dl[64 + j];
    s2 += dl[128 + j] * dl[192 + j];
  }
  const float lam = expf(s1) - expf(s2) + lam_init;
  float4* st = (float4*)(p.stash + ((size_t)blockIdx.x * 256 + tid) * 64);
  f32x16 O[4];
  float l;
  flash_core<64, 128>(p.dq + ((size_t)(hb * 2 + 0) * LP + qt * 128) * 64, p.dk + (size_t)(hb * 2 + 0) * LP * 64,
                      p.dvt + (size_t)hb * 128 * LP, nkt, O, l, smem);
  {
    const float inv = 1.f / l;
#pragma unroll
    for (int d = 0; d < 4; d++)
#pragma unroll
      for (int gq = 0; gq < 4; gq++)
        st[d * 4 + gq] = make_float4(O[d][4 * gq] * inv, O[d][4 * gq + 1] * inv, O[d][4 * gq + 2] * inv, O[d][4 * gq + 3] * inv);
  }
  flash_core<64, 128>(p.dq + ((size_t)(hb * 2 + 1) * LP + qt * 128) * 64, p.dk + (size_t)(hb * 2 + 1) * LP * 64,
                      p.dvt + (size_t)hb * 128 * LP, nkt, O, l, smem);
  const float inv2 = lam / l;
  float ss = 0.f;
#pragma unroll
  for (int d = 0; d < 4; d++)
#pragma unroll
    for (int gq = 0; gq < 4; gq++) {
      const float4 sv = st[d * 4 + gq];
      const float o0 = sv.x - O[d][4 * gq + 0] * inv2, o1 = sv.y - O[d][4 * gq + 1] * inv2;
      const float o2 = sv.z - O[d][4 * gq + 2] * inv2, o3 = sv.w - O[d][4 * gq + 3] * inv2;
      O[d][4 * gq + 0] = o0; O[d][4 * gq + 1] = o1; O[d][4 * gq + 2] = o2; O[d][4 * gq + 3] = o3;
      ss += o0 * o0 + o1 * o1 + o2 * o2 + o3 * o3;
    }
  ss += __shfl_xor(ss, 32);
  const float rs = rsqrtf(ss * (1.f / 128.f) + 1e-6f) * (1.f - lam_init);
  const float* sub = p.diff_subln + layer * 128;
  bf16_t* dst = p.ydiff + ((size_t)(bl * LP + qt * 128 + w * 32 + r)) * 512 + hd * 128;
#pragma unroll
  for (int d = 0; d < 4; d++)
#pragma unroll
    for (int gq = 0; gq < 4; gq++) {
      const int dv = d * 32 + 8 * gq + 4 * hh;
      const float4 sg = *(const float4*)(sub + dv);
      u32x2 u;
      u.x = pk2(O[d][4 * gq + 0] * rs * sg.x, O[d][4 * gq + 1] * rs * sg.y);
      u.y = pk2(O[d][4 * gq + 2] * rs * sg.z, O[d][4 * gq + 3] * rs * sg.w);
      *(u32x2*)(dst + dv) = u;
    }
}

constexpr int HQS = 136, HTS = 40;
struct HgLds {
  bf16_t *sQ, *sK, *sKT, *sVT;
  float *sER, *sA1, *sA2, *sTot;
};
DI HgLds hg_lds(char* smem) {
  HgLds L;
  L.sQ = (bf16_t*)smem;
  L.sK = L.sQ + 32 * HQS;
  L.sKT = L.sK + 32 * HQS;
  L.sVT = L.sKT + 128 * HTS;
  L.sER = (float*)(L.sVT + 128 * HTS);
  L.sA1 = L.sER + 128;
  L.sA2 = L.sA1 + 128;
  L.sTot = L.sA2 + 128;
  return L;
}
DI float hg_lower_bound(const Params& p, int dir, int layer, int col) {
  const float* lg = p.lb_logits + (size_t)dir * DEPTH * 512 + col;
  const float v0 = lg[0], v1 = lg[512], v2 = lg[1024], v3 = lg[1536];
  const float mx = fmaxf(fmaxf(v0, v1), fmaxf(v2, v3));
  const float e0 = expf(v0 - mx), e1 = expf(v1 - mx), e2 = expf(v2 - mx), e3 = expf(v3 - mx);
  const float inv = 1.f / (e0 + e1 + e2 + e3);
  float acc = 0.f;
  if (layer >= 1) acc += e1;
  if (layer >= 2) acc += e2;
  if (layer >= 3) acc += e3;
  return acc * inv;
}
DI float hg_stage(const Params& p, const HgLds& L, int dir, int hd, size_t row0, int rstep) {
  const int tid = tidx(), k = tid & 127, half = tid >> 7;
  const size_t cofs = hd * 128 + k;
  const bf16_t* gsrc = (dir ? p.gb : p.gf) + cofs;
  const bf16_t* ksrc = (dir ? p.zb : p.zf) + cofs;
  float bc[16];
  unsigned kq[16];
  bf16_t vr[16];
  float cum = 0.f;
#pragma unroll
  for (int uu = 0; uu < 16; uu++) {
    const int u = half * 16 + uu;
    const size_t row = row0 + (size_t)((long)rstep * u);
    const float gl = bf2f(gsrc[row * 512]);
    kq[uu] = (unsigned)ksrc[row * 512] | ((unsigned)p.hq[row * 512 + cofs] << 16);
    vr[uu] = p.hi[row * 512 + cofs];
    cum += gl;
    bc[uu] = cum;
  }
  __syncthreads();
  if (half == 0) L.sTot[k] = cum;
  __syncthreads();
  const float rref = L.sTot[k];
  float blast = 0.f;
  if (half == 1) {
    blast = rref + cum;
    L.sER[k] = __expf(rref);
    L.sA1[k] = __expf(blast);
    L.sA2[k] = __expf(blast - rref);
  }
  const float off = half ? 0.f : -rref;
#pragma unroll
  for (int uu = 0; uu < 16; uu++) {
    const int u = half * 16 + uu;
    const float e = fminf(fmaxf(bc[uu] + off, -80.f), 80.f);
    const float kvv = __uint_as_float(kq[uu] << 16);
    const float q = __uint_as_float(kq[uu] & 0xffff0000u);
    const float ee = __expf(e);
    const bf16_t kt = f2bf(kvv * __frcp_rn(ee));
    L.sQ[u * HQS + k] = f2bf(q * ee);
    L.sK[u * HQS + k] = kt;
    L.sKT[k * HTS + u] = kt;
    L.sVT[k * HTS + u] = vr[uu];
    if ((uu & 3) == 3) __builtin_amdgcn_sched_barrier(0);
  }
  __syncthreads();
  return blast;
}
DI void hg_update(const HgLds& L, f32x16 (&S)[4]) {
  const int lane = tidx() & 63, w = tidx() >> 6, r = lane & 31, hh = lane >> 5;
#pragma unroll
  for (int dkt = 0; dkt < 4; dkt++) {
    f32x16 T;
    zero16(T);
#pragma unroll
    for (int st = 0; st < 2; st++) {
      const bf16x8 a = *(const bf16x8*)(L.sKT + (dkt * 32 + r) * HTS + st * 16 + 8 * hh);
      const bf16x8 b = *(const bf16x8*)(L.sVT + (w * 32 + r) * HTS + st * 16 + 8 * hh);
      T = MFMA(a, b, T);
    }
#pragma unroll
    for (int gq = 0; gq < 4; gq++) {
      const int dk = dkt * 32 + 8 * gq + 4 * hh;
      const float4 a1 = *(const float4*)(L.sA1 + dk);
      const float4 a2 = *(const float4*)(L.sA2 + dk);
      S[dkt][4 * gq + 0] = a1.x * S[dkt][4 * gq + 0] + a2.x * T[4 * gq + 0];
      S[dkt][4 * gq + 1] = a1.y * S[dkt][4 * gq + 1] + a2.y * T[4 * gq + 1];
      S[dkt][4 * gq + 2] = a1.z * S[dkt][4 * gq + 2] + a2.z * T[4 * gq + 2];
      S[dkt][4 * gq + 3] = a1.w * S[dkt][4 * gq + 3] + a2.w * T[4 * gq + 3];
    }
  }
}
DI void hg_output(const HgLds& L, const f32x16 (&S)[4], f32x16& O) {
  const int lane = tidx() & 63, w = tidx() >> 6, r = lane & 31, hh = lane >> 5;
  f32x16 X;
  zero16(X);
#pragma unroll
  for (int ks = 0; ks < 8; ks++) {
    const bf16x8 a = *(const bf16x8*)(L.sK + r * HQS + ks * 16 + 8 * hh);
    const bf16x8 b = *(const bf16x8*)(L.sQ + r * HQS + ks * 16 + 8 * hh);
    X = MFMA(a, b, X);
  }
#pragma unroll
  for (int i = 0; i < 16; i++)
    if (crow(i, hh) > r) X[i] = 0.f;
  zero16(O);
#pragma unroll
  for (int st = 0; st < 2; st++) {
    const bf16x8 pf = pack8(X, st);
    const bf16_t* vp = L.sVT + (w * 32 + r) * HTS + 16 * st + 4 * hh;
    const bf16x8 vf = cat4(*(const bf16x4*)vp, *(const bf16x4*)(vp + 8));
    O = MFMA(vf, pf, O);
  }
#pragma unroll
  for (int dkt = 0; dkt < 4; dkt++) {
    f32x16 Ss;
#pragma unroll
    for (int gq = 0; gq < 4; gq++) {
      const float4 er = *(const float4*)(L.sER + dkt * 32 + 8 * gq + 4 * hh);
      Ss[4 * gq + 0] = S[dkt][4 * gq + 0] * er.x;
      Ss[4 * gq + 1] = S[dkt][4 * gq + 1] * er.y;
      Ss[4 * gq + 2] = S[dkt][4 * gq + 2] * er.z;
      Ss[4 * gq + 3] = S[dkt][4 * gq + 3] * er.w;
    }
#pragma unroll
    for (int st = 0; st < 2; st++) {
      const bf16x8 xs = pack8(Ss, st);
      const bf16_t* qp = L.sQ + r * HQS + dkt * 32 + 16 * st + 4 * hh;
      const bf16x8 qb = cat4(*(const bf16x4*)qp, *(const bf16x4*)(qp + 8));
      O = MFMA(xs, qb, O);
    }
  }
}
DI int hg_pos(int dir, int rng) { return dir == 0 ? rng : (rng == 0 ? 0 : NRNG - rng); }

DI void hg1_item(const Params& p, int layer, int sq, int rng, char* smem) {
  const HgLds L = hg_lds(smem);
  const int dir = sq & 1, hd = (sq >> 1) & 3, bl = sq >> 3;
  const int tid = tidx(), lane = tid & 63, w = tid >> 6, r = lane & 31, hh = lane >> 5;
  f32x16 S[4];
#pragma unroll
  for (int i = 0; i < 4; i++) zero16(S[i]);
  float btot = 0.f;
  const size_t rbase = (size_t)bl * LP + rng * 256;
  for (int c = 0; c < 8; c++) {
    const size_t row0 = dir ? rbase + 255 - c * 32 : rbase + c * 32;
    btot += hg_stage(p, L, dir, hd, row0, dir ? -1 : 1);
    hg_update(L, S);
  }
  const int pos = hg_pos(dir, rng);
  float* dst = p.hgst + ((size_t)sq * NRNG + pos) * 16384;
#pragma unroll
  for (int dkt = 0; dkt < 4; dkt++)
#pragma unroll
    for (int i = 0; i < 16; i++) dst[(dkt * 32 + crow(i, hh)) * 128 + w * 32 + r] = S[dkt][i];
  if (tid >= 128) p.hgdec[((size_t)sq * NRNG + pos) * 128 + (tid & 127)] = __expf(btot);
}
DI void hg2_item(const Params& p, int sq, int sl) {
  const int e = sl * 256 + tidx();
  const int dk = e >> 7;
  float* base = p.hgst + (size_t)sq * NRNG * 16384 + e;
  const float* dec = p.hgdec + (size_t)sq * NRNG * 128 + dk;
  float u[NRNG], dcy[NRNG];
#pragma unroll
  for (int pos = 0; pos < NRNG; pos++) {
    u[pos] = base[(size_t)pos * 16384];
    dcy[pos] = dec[pos * 128];
  }
  float S = 0.f;
#pragma unroll
  for (int pos = 0; pos < NRNG; pos++) {
    const float o = S;
    S = dcy[pos] * S + u[pos];
    u[pos] = o;
  }
#pragma unroll
  for (int pos = 0; pos < NRNG; pos++) base[(size_t)pos * 16384] = u[pos];
}
DI void hg3_item(const Params& p, int layer, int bh, int rng, char* smem) {
  const HgLds L = hg_lds(smem);
  const int hd = bh & 3, bl = bh >> 2;
  const int tid = tidx(), lane = tid & 63, w = tid >> 6, r = lane & 31, hh = lane >> 5;
  const size_t rbase = (size_t)bl * LP + rng * 256;
#pragma unroll 1
  for (int dir = 0; dir < 2; dir++) {
    const int sq = bh * 2 + dir;
    const int pos = hg_pos(dir, rng);
    const float* src = p.hgst + ((size_t)sq * NRNG + pos) * 16384;
    f32x16 S[4];
#pragma unroll
    for (int dkt = 0; dkt < 4; dkt++)
#pragma unroll
      for (int i = 0; i < 16; i++) S[dkt][i] = src[(dkt * 32 + crow(i, hh)) * 128 + w * 32 + r];
    if (dir == 1) __syncthreads();
#pragma unroll 1
    for (int c = 0; c < 8; c++) {
      const size_t row0 = dir ? rbase + 255 - c * 32 : rbase + c * 32;
      const size_t trow = dir ? row0 - r : row0 + r;
      float* od = p.osum + trow * 512 + hd * 128 + w * 32;
      float4 prev[4];
      if (dir == 1) {
#pragma unroll
        for (int gq = 0; gq < 4; gq++) prev[gq] = *(const float4*)(od + 8 * gq + 4 * hh);
      }
      hg_stage(p, L, dir, hd, row0, dir ? -1 : 1);
      f32x16 O;
      hg_output(L, S, O);
#pragma unroll
      for (int gq = 0; gq < 4; gq++) {
        float4 v = make_float4(O[4 * gq + 0], O[4 * gq + 1], O[4 * gq + 2], O[4 * gq + 3]);
        if (dir == 1) {
          v.x += prev[gq].x; v.y += prev[gq].y; v.z += prev[gq].z; v.w += prev[gq].w;
        }
        *(float4*)(od + 8 * gq + 4 * hh) = v;
      }
      if (c < 7) hg_update(L, S);
    }
  }
  __syncthreads();
  const float* gn = p.hg_norm + layer * 128;
  const float g0 = gn[2 * lane], g1 = gn[2 * lane + 1];
#pragma unroll 1
  for (int t0 = w; t0 < 256; t0 += 32) {
    float2 v[8];
    unsigned og[8];
#pragma unroll
    for (int q = 0; q < 8; q++) {
      const size_t row = rbase + t0 + 4 * q;
      v[q] = *(const float2*)(p.osum + row * 512 + hd * 128 + 2 * lane);
      og[q] = *(const unsigned*)(p.hog + row * 512 + hd * 128 + 2 * lane);
    }
#pragma unroll
    for (int q = 0; q < 8; q++) {
      const size_t row = rbase + t0 + 4 * q;
      float ss = v[q].x * v[q].x + v[q].y * v[q].y;
#pragma unroll
      for (int o = 32; o >= 1; o >>= 1) ss += __shfl_xor(ss, o);
      const float rs = rsqrtf(ss * (1.f / 128.f) + 1e-6f);
      const float o0 = __uint_as_float(og[q] << 16), o1 = __uint_as_float(og[q] & 0xffff0000u);
      *(unsigned*)(p.yhg + row * 512 + hd * 128 + 2 * lane) = pk2(v[q].x * rs * g0 * silu_f(o0), v[q].y * rs * g1 * silu_f(o1));
    }
  }
}

constexpr int MERGE_FULL = 1024, MERGE_ITEMS = MERGE_FULL + 64;
DI void merge_half_item(const Params& p, const bf16_t* hb, int layer, int mti, int nti, char* smem) {

  bf16_t* sA = (bf16_t*)smem;
  bf16_t* sB = sA + 128 * 72;
  const int m0 = mti * 128, n0 = nti * 64;
  const int lane = tidx() & 63, w = tidx() >> 6, wm = w >> 1, wn = w & 1, r = lane & 31, hh = lane >> 5;
  f32x16 mac[2];
  zero16(mac[0]);
  zero16(mac[1]);
  const int col = n0 + wn * 32 + r;
#pragma unroll 1
  for (int i = 0; i < 3; i++) {
    f32x16 ga[2][1], ba[2][1];
    zero16(ga[0][0]);
    zero16(ga[1][0]);
    gemm_core<1>(hb + (size_t)m0 * D, D, p.wg_t + ((size_t)i * D + n0) * D, D, D, ga, sA, sB);
    const float bg = p.b_gate[(layer * 3 + i) * D + col];
#pragma unroll
    for (int mt = 0; mt < 2; mt++)
#pragma unroll
      for (int j = 0; j < 16; j++) ga[mt][0][j] = sigmoid_f(ga[mt][0][j] + bg);
    zero16(ba[0][0]);
    zero16(ba[1][0]);
    const bf16_t* Y = i == 0 ? p.ymla : i == 1 ? p.yhg : p.ydiff;
    gemm_core<1>(Y + (size_t)m0 * 512, 512, p.wb_t + ((size_t)i * D + n0) * 512, 512, 512, ba, sA, sB);
#pragma unroll
    for (int mt = 0; mt < 2; mt++)
#pragma unroll
      for (int j = 0; j < 16; j++) mac[mt][j] += ga[mt][0][j] * ba[mt][0][j];
  }
#pragma unroll
  for (int mt = 0; mt < 2; mt++)
#pragma unroll
    for (int j = 0; j < 16; j++) {
      const int row = m0 + wm * 64 + mt * 32 + crow(j, hh);
      p.mbuf[(size_t)row * D + col] = f2bf(mac[mt][j]);
    }
}

DI void merge_item(const Params& p, const bf16_t* hb, int layer, int it, char* smem) {
  bf16_t* sA = (bf16_t*)smem;
  bf16_t* sB = sA + 128 * 72;
  int mti, nti;
  if (it >= MERGE_FULL) {
    patch_decode(MERGE_FULL + ((it - MERGE_FULL) >> 1), MT, 8, mti, nti);
    merge_half_item(p, hb, layer, mti, nti * 2 + ((it - MERGE_FULL) & 1), smem);
    return;
  }
  patch_decode(it, MT, 8, mti, nti);
  const int m0 = mti * 128, n0 = nti * 128;
  const int lane = tidx() & 63, w = tidx() >> 6, wm = w >> 1, wn = w & 1, r = lane & 31, hh = lane >> 5;
  unsigned mpk[2][2][8];
#pragma unroll
  for (int a = 0; a < 2; a++)
#pragma unroll
    for (int b = 0; b < 2; b++)
#pragma unroll
      for (int j = 0; j < 8; j++) mpk[a][b][j] = 0u;
#pragma unroll 1
  for (int i = 0; i < 3; i++) {
    unsigned gpk[2][2][8];
    {
      f32x16 ga[2][2];
#pragma unroll
      for (int a = 0; a < 2; a++)
#pragma unroll
        for (int b = 0; b < 2; b++) zero16(ga[a][b]);
      gemm_core1(hb + (size_t)m0 * D, D, p.wg_t + ((size_t)i * D + n0) * D, D, D, ga, sA, sB);
#pragma unroll
      for (int nt = 0; nt < 2; nt++) {
        const float bg = p.b_gate[(layer * 3 + i) * D + n0 + wn * 64 + nt * 32 + r];
#pragma unroll
        for (int mt = 0; mt < 2; mt++)
#pragma unroll
          for (int j = 0; j < 8; j++)
            gpk[mt][nt][j] = pk2(sigmoid_f(ga[mt][nt][2 * j] + bg), sigmoid_f(ga[mt][nt][2 * j + 1] + bg));
      }
    }
    f32x16 ba[2][2];
#pragma unroll
    for (int a = 0; a < 2; a++)
#pragma unroll
      for (int b = 0; b < 2; b++) zero16(ba[a][b]);
    const bf16_t* Y = i == 0 ? p.ymla : i == 1 ? p.yhg : p.ydiff;
    gemm_core1(Y + (size_t)m0 * 512, 512, p.wb_t + ((size_t)i * D + n0) * 512, 512, 512, ba, sA, sB);
#pragma unroll
    for (int mt = 0; mt < 2; mt++)
#pragma unroll
      for (int nt = 0; nt < 2; nt++)
#pragma unroll
        for (int j = 0; j < 8; j++) {
          const unsigned u = gpk[mt][nt][j], m = mpk[mt][nt][j];
          const float lo = __uint_as_float(m << 16) + __uint_as_float(u << 16) * ba[mt][nt][2 * j];
          const float hi = __uint_as_float(m & 0xffff0000u) + __uint_as_float(u & 0xffff0000u) * ba[mt][nt][2 * j + 1];
          mpk[mt][nt][j] = pk2(lo, hi);
        }
  }
#pragma unroll
  for (int mt = 0; mt < 2; mt++)
#pragma unroll
    for (int nt = 0; nt < 2; nt++)
#pragma unroll
      for (int j = 0; j < 16; j++) {
        const int row = m0 + wm * 64 + mt * 32 + crow(j, hh);
        const unsigned m = mpk[mt][nt][j >> 1];
        p.mbuf[(size_t)row * D + n0 + wn * 64 + nt * 32 + r] = (bf16_t)((j & 1) ? (m >> 16) : (m & 0xffffu));
      }
}

constexpr int RES_FULL = 1024, RES_ITEMS = RES_FULL + 64;
DI void resid_item(const Params& p, int g, int layer, int it, const bf16_t* A, int K, const bf16_t* Wt, int gate_off,
                   char* smem) {
  bf16_t* sA = (bf16_t*)smem;
  bf16_t* sB = sA + 128 * 72;
  const int lane = tidx() & 63, w = tidx() >> 6, wm = w >> 1, wn = w & 1, r = lane & 31, hh = lane >> 5;
  if (it >= RES_FULL) {
    int mti, nti;
    patch_decode(RES_FULL + ((it - RES_FULL) >> 1), MT, 8, mti, nti);
    const int m0 = mti * 128, n0 = nti * 128 + ((it - RES_FULL) & 1) * 64;
    f32x16 acc[2][1];
    zero16(acc[0][0]);
    zero16(acc[1][0]);
    gemm_core<1>(A + (size_t)m0 * K, K, Wt + (size_t)n0 * K, K, K, acc, sA, sB);
    const float* md = mod_row(p, g, layer, m0) + gate_off;
    const float* xs = xsrc_row(p, g, gate_off == 2 * D ? layer : 1, m0);
    float* xd = xdst_row(p, g, m0);
    const int col = n0 + wn * 32 + r;
    const float gt = md[col];
#pragma unroll
    for (int mt = 0; mt < 2; mt++) {
#pragma unroll
      for (int i = 0; i < 16; i++) {
        const int ro = (wm * 64 + mt * 32 + crow(i, hh)) * D + col;
        xd[ro] = ALPHA * xs[ro] + gt * acc[mt][0][i];
      }
      __builtin_amdgcn_sched_barrier(0);
    }
    return;
  }
  int mti, nti;
  patch_decode(it, MT, 8, mti, nti);
  const int m0 = mti * 128, n0 = nti * 128;
  f32x16 acc[2][2];
#pragma unroll
  for (int a = 0; a < 2; a++)
#pragma unroll
    for (int b = 0; b < 2; b++) zero16(acc[a][b]);
  gemm_core<2>(A + (size_t)m0 * K, K, Wt + (size_t)n0 * K, K, K, acc, sA, sB);
  const float* md = mod_row(p, g, layer, m0) + gate_off;
  const float* xs = xsrc_row(p, g, gate_off == 2 * D ? layer : 1, m0);
  float* xd = xdst_row(p, g, m0);
#pragma unroll
  for (int nt = 0; nt < 2; nt++) {
    const int col = n0 + wn * 64 + nt * 32 + r;
    const float gt = md[col];
#pragma unroll
    for (int mt = 0; mt < 2; mt++) {
#pragma unroll
      for (int i = 0; i < 16; i++) {
        const int ro = (wm * 64 + mt * 32 + crow(i, hh)) * D + col;
        xd[ro] = ALPHA * xs[ro] + gt * acc[mt][nt][i];
      }
      __builtin_amdgcn_sched_barrier(0);
    }
  }
}

DI void ffn1_item(const Params& p, const bf16_t* hb, int it, char* smem) {
  bf16_t* sA = (bf16_t*)smem;
  bf16_t* sB = sA + 128 * 72;
  int mti, nti;
  patch_decode(it, MT, 22, mti, nti);
  const int m0 = mti * 128, n0 = nti * 256;
  f32x16 acc[2][4];
#pragma unroll
  for (int a = 0; a < 2; a++)
#pragma unroll
    for (int b = 0; b < 4; b++) zero16(acc[a][b]);
  gemm_core_wide(hb + (size_t)m0 * D, D, p.wff1_t + (size_t)n0 * D, D, D, acc, sA, sB);
  const int lane = tidx() & 63, w = tidx() >> 6, wm = w >> 1, wn = w & 1, r = lane & 31, hh = lane >> 5;
#pragma unroll
  for (int pr = 0; pr < 2; pr++) {
    const int col = nti * 128 + wn * 64 + pr * 32 + r;
#pragma unroll
    for (int mt = 0; mt < 2; mt++)
#pragma unroll
      for (int i = 0; i < 16; i++) {
        const int row = m0 + wm * 64 + mt * 32 + crow(i, hh);
        p.hid[(size_t)row * FFH + col] = f2bf(silu_f(acc[mt][2 * pr][i]) * acc[mt][2 * pr + 1][i]);
      }
  }
}

#define XCD_LOOP(N, L)                                                     \
  for (int k_ = 0, nb8_ = nblk >> 3; k_ * 8 * nb8_ < (N); k_++)            \
    for (int L = (k_ * 8 + (bid & 7)) * nb8_ + (bid >> 3), o_ = 1; o_ && L < (N); o_ = 0)
#define XCD_LOOP_SPREAD(N, L)                                                                          \
  for (int ph_ = 0, nf_ = ((N) / nblk) * nblk; ph_ < 2; ph_++)                                          \
    for (int k_ = 0, nb8_ = nblk >> 3; ph_ == 0 ? (k_ * 8 * nb8_ < nf_) : (k_ == 0); k_++)              \
      for (int L = ph_ == 0 ? (k_ * 8 + (bid & 7)) * nb8_ + (bid >> 3) : nf_ + bid, o_ = 1;             \
           o_ && L < (ph_ == 0 ? nf_ : (N)); o_ = 0)
#define XB_TMO      128
#define XB_XCNT(j)  (256  + 64 * (j))
#define XB_XSUB(j)  (1280 + 64 * (j))
#define XB_XGEN(j)  (2304 + 64 * (j))
#define XB_TOP      3328
#define XB_TOPGEN   3392
#define XCD_BAR_WORDS 3456
#define XB_SPIN_CAP (1u << 20)
#define LAS __attribute__((address_space(3)))
DI unsigned xb_ld(unsigned* p) { return __hip_atomic_load(p, __ATOMIC_RELAXED, __HIP_MEMORY_SCOPE_AGENT); }
DI unsigned xb_add(unsigned* p, unsigned v) { return __hip_atomic_fetch_add(p, v, __ATOMIC_RELAXED, __HIP_MEMORY_SCOPE_AGENT); }
DI unsigned xb_xcc_id() { return (unsigned)__builtin_amdgcn_s_getreg((3 << 11) | 20) & 0xFu; }
#define XB_SPIN(cond, bar) do { unsigned _sp = 0; while (cond) { __builtin_amdgcn_s_sleep(1); \
    if ((++_sp & 255u) == 0u) { if (xb_ld(&(bar)[XB_TMO])) break; if (_sp > XB_SPIN_CAP) { atomicAdd(&(bar)[XB_TMO], 1u); break; } } } } while (0)
struct XcdBarrier {
  unsigned* bar;
  unsigned x;
  volatile LAS unsigned* st;
};
DI XcdBarrier xcd_barrier_post(unsigned* bar, volatile LAS unsigned* st) {
  XcdBarrier b;
  b.bar = bar;
  b.x = xb_xcc_id();
  b.st = st;
  if (threadIdx.x == 0) (void)xb_add(&bar[XB_XCNT(b.x)], 1u);
  return b;
}
DI void xcd_barrier_complete(unsigned* bar, unsigned x, unsigned& nloc, unsigned& nx) {
  const unsigned G = gridDim.x * gridDim.y * gridDim.z;
  unsigned sum, cnt, mine, sp = 0u;
  for (;;) {
    sum = 0u; cnt = 0u; mine = 0u;
#pragma unroll
    for (unsigned j = 0; j < 16; ++j) {
      const unsigned c = xb_ld(&bar[XB_XCNT(j)]);
      sum += c;
      cnt += (c > 0u) ? 1u : 0u;
      mine = (j == x) ? c : mine;
    }
    if (sum == G) break;
    __builtin_amdgcn_s_sleep(1);
    if ((++sp & 255u) == 0u) {
      if (xb_ld(&bar[XB_TMO])) break;
      if (sp > XB_SPIN_CAP) { atomicAdd(&bar[XB_TMO], 1u); break; }
    }
  }
  nloc = mine > 0u ? mine : 1u;
  nx = cnt > 0u ? cnt : 1u;
}
DI void xcd_barrier(const XcdBarrier& b) {
  asm volatile("s_waitcnt vmcnt(0)" ::: "memory");
  __syncthreads();
  if (threadIdx.x == 0) {
    unsigned* bar = b.bar;
    __builtin_amdgcn_s_waitcnt(0);
    unsigned nloc = b.st[0], nx = b.st[1];
    if (nloc == 0u) {
      xcd_barrier_complete(bar, b.x, nloc, nx);
      b.st[0] = nloc;
      b.st[1] = nx;
    }
    const unsigned old = xb_add(&bar[XB_XSUB(b.x)], 1u);
    const unsigned gen = old / nloc;
    if (old + 1u == (gen + 1u) * nloc) {
      __builtin_amdgcn_fence(__ATOMIC_RELEASE, "agent");
      asm volatile("s_waitcnt vmcnt(0)" ::: "memory");
      const unsigned og = xb_add(&bar[XB_TOP], 1u);
      const unsigned tg = og / nx;
      if (og + 1u == (tg + 1u) * nx) xb_add(&bar[XB_TOPGEN], 1u);
      else XB_SPIN(xb_ld(&bar[XB_TOPGEN]) == tg, bar);
      __builtin_amdgcn_fence(__ATOMIC_ACQUIRE, "agent");
      xb_add(&bar[XB_XGEN(b.x)], 1u);
      asm volatile("s_waitcnt vmcnt(0)" ::: "memory");
    } else {
      XB_SPIN(xb_ld(&bar[XB_XGEN(b.x)]) == gen, bar);
      __builtin_amdgcn_fence(__ATOMIC_ACQUIRE, "agent");
      asm volatile("s_waitcnt vmcnt(0)" ::: "memory");
    }
  }
  __syncthreads();
}

DI void dep_publish(unsigned* c1, unsigned* c2) {
  asm volatile("s_waitcnt vmcnt(0)" ::: "memory");
  __syncthreads();
  if (threadIdx.x == 0) {
    __builtin_amdgcn_fence(__ATOMIC_RELEASE, "agent");
    asm volatile("s_waitcnt vmcnt(0)" ::: "memory");
    xb_add(c1, 1u);
    if (c2) xb_add(c2, 1u);
  }
}
DI void dep_wait(unsigned* c, unsigned target, unsigned* bar) {
  if (threadIdx.x == 0) {
    XB_SPIN(xb_ld(c) < target, bar);
    __builtin_amdgcn_fence(__ATOMIC_ACQUIRE, "agent");
    asm volatile("s_waitcnt vmcnt(0)" ::: "memory");
  }
  __syncthreads();
}

__global__ void __launch_bounds__(256, 2) mega_kernel(Params p, float li0, float li1, float li2, float li3, int repD, int repG, int repH) {
  __shared__ __attribute__((aligned(16))) char smem[SMEM_BYTES];
  cg::grid_group grid = cg::this_grid();
  const int nblk = gridDim.x, bid = blockIdx.x;
  __shared__ uint4 xb_words;
  if (threadIdx.x == 0) xb_words = make_uint4(0u, 0u, 0u, 0u);
  if (bid == 0) {
    for (int e = tidx(); e < XCD_BAR_WORDS; e += 256) p.xbar[e] = 0u;
    for (int e = tidx(); e < NGRP * DEPTH * 512; e += 256) p.dep[e] = 0u;
    p.qctr[tidx()] = 0u;
  }
  __syncthreads();
  for (int it = bid; it < 384 + CV_TOTAL; it += nblk) {
    if (it < 384) mod_item(p, it, smem);
    else conv_item(p, 0, it - 384, smem);
  }
  grid.sync();
  const XcdBarrier xb = xcd_barrier_post(p.xbar, (volatile LAS unsigned*)&xb_words);
  const int rpb = (TG + nblk - 1) / nblk;
  const int rp0 = min(TG, bid * rpb), rp1 = min(TG, rp0 + rpb);
#pragma unroll 1
  for (int g = 0; g < NGRP; g++) {
    rowpass_rows(p, p.h + (size_t)g * TG * D, g, rp0, rp1, 0, 0, nullptr, nullptr, 0, 0, true);
  }
  xcd_barrier(xb);
#pragma unroll 1
  for (int layer = 0; layer < DEPTH; layer++) {
#pragma unroll 1
    for (int g = 0; g < NGRP; g++) {
      bf16_t* hb = p.h + (size_t)g * TG * D;
      const float lam_init = layer == 0 ? li0 : layer == 1 ? li1 : layer == 2 ? li2 : li3;
#pragma unroll 1
      for (int rep = 0; rep < repG; rep++)
      XCD_LOOP_SPREAD(MT * 36, it) inproj_item(p, hb, layer, it, smem);
      xcd_barrier(xb);
#pragma unroll 1
      for (int rep = 1; rep < repD; rep++) xcd_barrier(xb);
      {
        constexpr int N2 = MT * 6, N3 = MT * 8, N4 = MT;
        unsigned* ctr = p.qctr + 64 + (g * DEPTH + layer);
        int* sNext = (int*)(smem + SMEM_BYTES - 16);
        for (;;) {
          __syncthreads();
          if (tidx() == 0) *sNext = (int)atomicAdd(ctr, 1u);
          __syncthreads();
          const int it = *sNext;
          if (it >= N2 + N3 + N4) break;
          if (it < N4) kpe_item(p, it);
          else if (it < N4 + N2) upq_item(p, it - N4, smem);
          else upkv_item(p, it - N4 - N2, smem);
        }
      }
      xcd_barrier(xb);
      {
        static_assert(GB * 4 == 8 && GB * 8 == 16, "attention queue assumes 8 diff heads / 16 MLA heads per group");
        const int xhome = (int)(xb.x & 7u);
        int* sNext = (int*)(smem + SMEM_BYTES - 16);
        constexpr int QA = 32, QB_ = QA + 2 * NRNG, QC = QB_ + 34, QD = QC + 128, QE = QD + NRNG, QF = QE + 132;
#pragma unroll 1
        for (int qd = 0; qd < 8; qd++) {
          const int xq = (xhome + qd) & 7;
          unsigned* dep = p.dep + (g * DEPTH + layer) * 512 + xq * 8;
          unsigned* ctr = p.qctr + (g * DEPTH + layer) * 8 + xq;
          bool rdy1a = false, rdy1b = false, rdy2 = false;
          for (;;) {
            __syncthreads();
            if (tidx() == 0) *sNext = (int)atomicAdd(ctr, 1u);
            __syncthreads();
            const int it = *sNext;
            if (it >= QF) break;
            if (it < QA) {
              diff_item(p, layer, lam_init, xq, (it + 2) % 66, smem);
            } else if (it < QB_) {
              const int j = it - QA, dir = j / NRNG, rng = j % NRNG;
              hg1_item(p, layer, xq * 2 + dir, rng, smem);
              dep_publish(dep + dir, nullptr);
            } else if (it < QC) {
              diff_item(p, layer, lam_init, xq, (it - QB_ + QA + 2) % 66, smem);
            } else if (it < QD) {
              const int j = it - QC, dir = j >> 6, sl = j & 63;
              if (!(dir ? rdy1b : rdy1a)) {
                dep_wait(dep + dir, (unsigned)NRNG, p.xbar);
                if (dir) rdy1b = true; else rdy1a = true;
              }
              hg2_item(p, xq * 2 + dir, sl);
              dep_publish(dep + 2, nullptr);
            } else if (it < QE) {
              if (!rdy2) {
                dep_wait(dep + 2, 128u, p.xbar);
                rdy2 = true;
              }
              hg3_item(p, layer, xq, it - QD, smem);
            } else {
              const int j = it - QE;
              mla_item(p, 2 * xq + j / 66, (j % 66 + 2) % 66, smem);
            }
          }
        }
      }
      xcd_barrier(xb);
#pragma unroll 1
      for (int rep = 0; rep < repG; rep++)
      XCD_LOOP(MERGE_FULL, it) merge_item(p, hb, layer, it, smem);
      for (int it = MERGE_FULL + bid; it < MERGE_ITEMS; it += nblk) merge_item(p, hb, layer, it, smem);
      xcd_barrier(xb);
      XCD_LOOP(RES_FULL, it) resid_item(p, g, layer, it, p.mbuf, D, p.wo_t, 2 * D, smem);
      for (int it = RES_FULL + bid; it < RES_ITEMS; it += nblk) resid_item(p, g, layer, it, p.mbuf, D, p.wo_t, 2 * D, smem);
      xcd_barrier(xb);
      rowpass_rows(p, hb, g, rp0, rp1, 1, 1, p.ln1_g + layer * D, p.ln1_b + layer * D, layer, 3 * D, true);
      xcd_barrier(xb);
#pragma unroll 1
      for (int rep = 0; rep < repG; rep++)
      XCD_LOOP_SPREAD(MT * 22, it) ffn1_item(p, hb, it, smem);
      xcd_barrier(xb);
      XCD_LOOP(RES_FULL, it) resid_item(p, g, layer, it, p.hid, FFH, p.wff2_t, 5 * D, smem);
      for (int it = RES_FULL + bid; it < RES_ITEMS; it += nblk) resid_item(p, g, layer, it, p.hid, FFH, p.wff2_t, 5 * D, smem);
      xcd_barrier(xb);
      {
        const bool last_layer = layer == DEPTH - 1;
        rowpass_rows(p, hb, g, rp0, rp1, 1, 1, p.ln2_g + layer * D, p.ln2_b + layer * D, layer + 1, 0, !last_layer);
        if (g == NGRP - 1 && !last_layer)
          for (int it = bid; it < CV_TOTAL; it += nblk) conv_item(p, layer + 1, it, smem);
      }
      xcd_barrier(xb);
    }
  }
}

static inline size_t align_up(size_t v) { return (v + 255) & ~(size_t)255; }

extern "C" void kernel_launch(void* const* d_in, const int* in_sizes, int n_in, void* d_out, int out_size, void* d_ws,
                              size_t ws_size, hipStream_t stream) {
  static int grid_blocks = 0;
  if (!grid_blocks) {
    int dev = 0, cus = 0, per_cu = 0;
    hipGetDevice(&dev);
    hipDeviceGetAttribute(&cus, hipDeviceAttributeMultiprocessorCount, dev);
    hipOccupancyMaxActiveBlocksPerMultiprocessor(&per_cu, mega_kernel, 256, 0);
    if (per_cu > 2) per_cu = 2;
    if (per_cu < 1) per_cu = 1;
    grid_blocks = cus * per_cu;
  }
  Params p{};
  const float* const* in = (const float* const*)d_in;
  p.x = in[0]; p.c = in[1]; p.ctx = in[2]; p.c_ctx = in[3]; p.w_mod = in[4]; p.b_mod = in[5]; p.w_in = in[6];
  p.qn = in[7]; p.kvn = in[8]; p.w_uq = in[9]; p.w_ukv = in[10]; p.lb_logits = in[11]; p.hg_norm = in[12];
  p.diff_lambda = in[13]; p.diff_subln = in[14]; p.w_branch = in[15]; p.w_gate = in[16]; p.b_gate = in[17];
  p.w_o = in[18]; p.ln1_g = in[19]; p.ln1_b = in[20]; p.w_ff1 = in[21]; p.w_ff2 = in[22]; p.ln2_g = in[23]; p.ln2_b = in[24];
  p.out = (float*)d_out;
  char* ws = (char*)d_ws;
  size_t off = 0;
  auto take = [&](size_t bytes) { char* r = ws + off; off = align_up(off + bytes); return r; };
  p.mod = (float*)take((size_t)DEPTH * 5 * 6 * D * 4);
  p.ctxres = (float*)take((size_t)NBATCH * CTX * D * 4);
  p.win_t = (bf16_t*)take((size_t)INWP * D * 2);
  p.wuq_t = (bf16_t*)take((size_t)768 * 256 * 2);
  p.wukv_t = (bf16_t*)take((size_t)1024 * 128 * 2);
  p.wg_t = (bf16_t*)take((size_t)3 * D * D * 2);
  p.wb_t = (bf16_t*)take((size_t)3 * D * 512 * 2);
  p.wo_t = (bf16_t*)take((size_t)D * D * 2);
  p.wff1_t = (bf16_t*)take((size_t)2 * FFH * D * 2);
  p.wff2_t = (bf16_t*)take((size_t)D * FFH * 2);
  p.h = (bf16_t*)take((size_t)NGRP * TG * D * 2);
  p.cbuf = (bf16_t*)take((size_t)TG * 416 * 2);
  p.Qm = (bf16_t*)take((size_t)TG * 768 * 2);
  p.Km = (bf16_t*)take((size_t)TG * 768 * 2);
  p.mbuf = p.Qm;
  p.Vtm = (bf16_t*)take((size_t)TG * 512 * 2);
  p.hq = (bf16_t*)take((size_t)TG * 512 * 2);
  p.zf = (bf16_t*)take((size_t)TG * 512 * 2);
  p.zb = (bf16_t*)take((size_t)TG * 512 * 2);
  p.hi = (bf16_t*)take((size_t)TG * 512 * 2);
  p.hog = (bf16_t*)take((size_t)TG * 512 * 2);
  p.dq = (bf16_t*)take((size_t)TG * 512 * 2);
  p.hid = p.hq;
  p.dk = (bf16_t*)take((size_t)TG * 512 * 2);
  p.dvt = (bf16_t*)take((size_t)TG * 512 * 2);
  p.gf = (bf16_t*)take((size_t)TG * 512 * 2);
  p.gb = (bf16_t*)take((size_t)TG * 512 * 2);
  p.ymla = (bf16_t*)take((size_t)TG * 512 * 2);
  p.yhg = (bf16_t*)take((size_t)TG * 512 * 2);
  p.ydiff = (bf16_t*)take((size_t)TG * 512 * 2);
  p.hgst = (float*)take((size_t)GB * 4 * 2 * NRNG * 16384 * 4);
  p.hgdec = (float*)take((size_t)GB * 4 * 2 * NRNG * 128 * 4);
  p.osum = (float*)take((size_t)TG * 512 * 4);
  p.stash = (float*)take((size_t)grid_blocks * 64 * 256 * 4);
  p.qctr = (unsigned*)take(256 * 4);
  p.xbar = (unsigned*)take(XCD_BAR_WORDS * 4);
  p.dep = (unsigned*)take((size_t)NGRP * DEPTH * 512 * 4);
  if (off > ws_size) {
    fprintf(stderr, "workspace too small: need %zu have %zu\n", off, ws_size);
    return;
  }
  float li0 = 0.8f - 0.6f * expf(-0.3f * 0.f), li1 = 0.8f - 0.6f * expf(-0.3f * 1.f), li2 = 0.8f - 0.6f * expf(-0.3f * 2.f),
        li3 = 0.8f - 0.6f * expf(-0.3f * 3.f);
  int repD = REP_D, repG = REP_G, repH = REP_H;
  void* args[] = {&p, &li0, &li1, &li2, &li3, &repD, &repG, &repH};
  hipError_t e = hipLaunchCooperativeKernel((void*)mega_kernel, dim3(grid_blocks), dim3(256), args, 0, stream);
  if (e != hipSuccess) fprintf(stderr, "cooperative launch failed: %s (grid %d)\n", hipGetErrorString(e), grid_blocks);
}
```

```cpp
#include <hip/hip_runtime.h>
#include <hip/hip_cooperative_groups.h>
#include <cstdio>
namespace cg = cooperative_groups;

#define DI __device__ __forceinline__
typedef unsigned short bf16_t;
typedef __attribute__((ext_vector_type(8))) short bf16x8;
typedef __attribute__((ext_vector_type(4))) short bf16x4;
typedef __attribute__((ext_vector_type(16))) float f32x16;
typedef unsigned u32x4 __attribute__((ext_vector_type(4)));
typedef unsigned u32x2 __attribute__((ext_vector_type(2)));
typedef __bf16 bfv2 __attribute__((ext_vector_type(2)));
typedef float fv2 __attribute__((ext_vector_type(2)));
#define MFMA(a, b, c) __builtin_amdgcn_mfma_f32_32x32x16_bf16((a), (b), (c), 0, 0, 0)

constexpr int D = 1024;
constexpr int NBATCH = 4;
constexpr int SEQ = 8192;
constexpr int CTX = 256;
constexpr int LP = SEQ + CTX;
constexpr int GB = 2;
constexpr int NGRP = NBATCH / GB;
constexpr int TG = GB * LP;
constexpr int MT = TG / 128;
constexpr int DEPTH = 4;
constexpr int INW = 4512;
constexpr int INWP = 4608;
constexpr int FFH = 2816;
constexpr int NRNG = 33;
constexpr float LOG2E = 1.4426950408889634f;
constexpr float MLA_QSCALE = 0.10206207261596577f * LOG2E;
constexpr float DIFF_QSCALE = 0.125f * LOG2E;
constexpr float HG_SCALE = 0.08838834764831845f;
constexpr float ALPHA = 1.681792830507429f;
constexpr float LOG2_10000 = 13.287712379549449f;
constexpr int SMEM_BYTES = 54 * 1024 + 64;
#ifndef REP_D
#define REP_D 1
#endif
#ifndef REP_G
#define REP_G 1
#endif
#ifndef REP_H
#define REP_H 1
#endif

struct Params {
  const float *x, *c, *ctx, *c_ctx, *w_mod, *b_mod, *w_in, *qn, *kvn, *w_uq, *w_ukv, *lb_logits, *hg_norm,
      *diff_lambda, *diff_subln, *w_branch, *w_gate, *b_gate, *w_o, *ln1_g, *ln1_b, *w_ff1, *w_ff2, *ln2_g, *ln2_b;
  float* out;
  float *mod, *ctxres;
  bf16_t *win_t, *wuq_t, *wukv_t, *wg_t, *wb_t, *wo_t, *wff1_t, *wff2_t;
  bf16_t *h, *cbuf, *Qm, *Km, *Vtm, *hq, *zf, *zb, *gf, *gb, *hi, *hog, *dq, *dk, *dvt, *ymla, *yhg, *ydiff, *mbuf, *hid;
  float *hgst, *hgdec, *osum, *stash;
  unsigned* qctr;
  unsigned* xbar;
  unsigned* dep;
};

DI int tidx() {
  int t = threadIdx.x;
  asm volatile("" : "+v"(t));
  return t;
}
DI float bf2f(bf16_t v) { return __uint_as_float(((unsigned)v) << 16); }
DI unsigned pk2(float a, float b) {
  fv2 v = {a, b};
  bfv2 r = __builtin_convertvector(v, bfv2);
  return __builtin_bit_cast(unsigned, r);
}
DI bf16_t f2bf(float a) { return (bf16_t)(pk2(a, 0.f) & 0xffffu); }
DI int crow(int i, int hh) { return (i & 3) + 8 * (i >> 2) + 4 * hh; }
DI float silu_f(float x) { return x / (1.f + __expf(-x)); }
DI float sigmoid_f(float x) { return 1.f / (1.f + __expf(-x)); }
DI bf16x8 pack8(const f32x16& x, const int s) {
  u32x4 u;
  u.x = pk2(x[8 * s + 0], x[8 * s + 1]);
  u.y = pk2(x[8 * s + 2], x[8 * s + 3]);
  u.z = pk2(x[8 * s + 4], x[8 * s + 5]);
  u.w = pk2(x[8 * s + 6], x[8 * s + 7]);
  return __builtin_bit_cast(bf16x8, u);
}
DI float xor32_max(float v) {
  auto r = __builtin_amdgcn_permlane32_swap(__float_as_uint(v), __float_as_uint(v), false, false);
  return fmaxf(__uint_as_float(r[0]), __uint_as_float(r[1]));
}
DI bf16x8 cat4(bf16x4 lo, bf16x4 hi) { return __builtin_shufflevector(lo, hi, 0, 1, 2, 3, 4, 5, 6, 7); }
DI void zero16(f32x16& a) {
#pragma unroll
  for (int i = 0; i < 16; i++) a[i] = 0.f;
}

DI void patch_decode(int L, int mtiles, int ntiles, int& m, int& n) {
  const int per = 8 * ntiles;
  const int sr = L / per, q = L - sr * per;
  const int mc = min(8, mtiles - sr * 8);
  n = q / mc;
  m = sr * 8 + (q - n * mc);
}

DI const float* xsrc_row(const Params& p, int g, int layer, int row) {
  const int bl = row / LP, pp = row - bl * LP, b = g * GB + bl;
  if (pp < CTX) return (layer == 0 ? p.ctx : p.ctxres) + ((size_t)(b * CTX + pp)) * D;
  return (layer == 0 ? p.x : p.out) + ((size_t)b * SEQ + (pp - CTX)) * D;
}
DI float* xdst_row(const Params& p, int g, int row) {
  const int bl = row / LP, pp = row - bl * LP, b = g * GB + bl;
  if (pp < CTX) return p.ctxres + ((size_t)(b * CTX + pp)) * D;
  return p.out + ((size_t)b * SEQ + (pp - CTX)) * D;
}
DI const float* mod_row(const Params& p, int g, int layer, int row) {
  const int bl = row / LP, pp = row - bl * LP, b = g * GB + bl;
  return p.mod + ((size_t)(layer * 5 + (pp < CTX ? 4 : b))) * (6 * D);
}

template <int TN>
DI void gemm_core(const bf16_t* __restrict__ A, int lda, const bf16_t* __restrict__ Bt, int ldb, int K,
                  f32x16 (&acc)[2][TN], bf16_t* sA, bf16_t* sB) {
  const int tid = tidx(), lane = tid & 63, w = tid >> 6;
  const int wm = w >> 1, wn = w & 1, r = lane & 31, hh = lane >> 5;
  const int lrow = tid >> 3, lk = (tid & 7) * 8;
  constexpr int NB = 2 * TN;
  u32x4 ra0[4], rb0[NB], ra1[4], rb1[NB];
  const bf16_t* Ap = A + (size_t)lrow * lda + lk;
  const bf16_t* Bp = Bt + (size_t)lrow * ldb + lk;
  const int nk = K >> 6;
#pragma unroll
  for (int i = 0; i < 4; i++) ra0[i] = *(const u32x4*)(Ap + (size_t)(32 * i) * lda);
#pragma unroll
  for (int i = 0; i < NB; i++) rb0[i] = *(const u32x4*)(Bp + (size_t)(32 * i) * ldb);
#pragma unroll
  for (int i = 0; i < 4; i++) ra1[i] = *(const u32x4*)(Ap + 64 + (size_t)(32 * i) * lda);
#pragma unroll
  for (int i = 0; i < NB; i++) rb1[i] = *(const u32x4*)(Bp + 64 + (size_t)(32 * i) * ldb);
  auto compute = [&]() {
#pragma unroll
    for (int ks = 0; ks < 4; ks++) {
      bf16x8 af[2], bfr[TN];
#pragma unroll
      for (int mt = 0; mt < 2; mt++) af[mt] = *(const bf16x8*)(sA + (wm * 64 + mt * 32 + r) * 72 + ks * 16 + hh * 8);
#pragma unroll
      for (int nt = 0; nt < TN; nt++) bfr[nt] = *(const bf16x8*)(sB + (wn * 32 * TN + nt * 32 + r) * 72 + ks * 16 + hh * 8);
#pragma unroll
      for (int mt = 0; mt < 2; mt++)
#pragma unroll
        for (int nt = 0; nt < TN; nt++) acc[mt][nt] = MFMA(af[mt], bfr[nt], acc[mt][nt]);
    }
  };
  for (int kt = 0; kt < nk; kt += 2) {
    __syncthreads();
#pragma unroll
    for (int i = 0; i < 4; i++) *(u32x4*)(sA + (lrow + 32 * i) * 72 + lk) = ra0[i];
#pragma unroll
    for (int i = 0; i < NB; i++) *(u32x4*)(sB + (lrow + 32 * i) * 72 + lk) = rb0[i];
    __syncthreads();
    if (kt + 2 < nk) {
#pragma unroll
      for (int i = 0; i < 4; i++) ra0[i] = *(const u32x4*)(Ap + (kt + 2) * 64 + (size_t)(32 * i) * lda);
#pragma unroll
      for (int i = 0; i < NB; i++) rb0[i] = *(const u32x4*)(Bp + (kt + 2) * 64 + (size_t)(32 * i) * ldb);
    }
    __builtin_amdgcn_sched_barrier(0);
    compute();
    __syncthreads();
#pragma unroll
    for (int i = 0; i < 4; i++) *(u32x4*)(sA + (lrow + 32 * i) * 72 + lk) = ra1[i];
#pragma unroll
    for (int i = 0; i < NB; i++) *(u32x4*)(sB + (lrow + 32 * i) * 72 + lk) = rb1[i];
    __syncthreads();
    if (kt + 3 < nk) {
#pragma unroll
      for (int i = 0; i < 4; i++) ra1[i] = *(const u32x4*)(Ap + (kt + 3) * 64 + (size_t)(32 * i) * lda);
#pragma unroll
      for (int i = 0; i < NB; i++) rb1[i] = *(const u32x4*)(Bp + (kt + 3) * 64 + (size_t)(32 * i) * ldb);
    }
    __builtin_amdgcn_sched_barrier(0);
    compute();
  }
}

DI void gemm_core1(const bf16_t* __restrict__ A, int lda, const bf16_t* __restrict__ Bt, int ldb, int K,
                   f32x16 (&acc)[2][2], bf16_t* sA, bf16_t* sB) {
  const int tid = tidx(), lane = tid & 63, w = tid >> 6;
  const int wm = w >> 1, wn = w & 1, r = lane & 31, hh = lane >> 5;
  const int lrow = tid >> 3, lk = (tid & 7) * 8;
  u32x4 ra[4], rb[4];
  const bf16_t* Ap = A + (size_t)lrow * lda + lk;
  const bf16_t* Bp = Bt + (size_t)lrow * ldb + lk;
#pragma unroll
  for (int i = 0; i < 4; i++) ra[i] = *(const u32x4*)(Ap + (size_t)(32 * i) * lda);
#pragma unroll
  for (int i = 0; i < 4; i++) rb[i] = *(const u32x4*)(Bp + (size_t)(32 * i) * ldb);
  const int nk = K >> 6;
  for (int kt = 0; kt < nk; kt++) {
    __syncthreads();
#pragma unroll
    for (int i = 0; i < 4; i++) *(u32x4*)(sA + (lrow + 32 * i) * 72 + lk) = ra[i];
#pragma unroll
    for (int i = 0; i < 4; i++) *(u32x4*)(sB + (lrow + 32 * i) * 72 + lk) = rb[i];
    __syncthreads();
    if (kt + 1 < nk) {
      Ap += 64;
      Bp += 64;
#pragma unroll
      for (int i = 0; i < 4; i++) ra[i] = *(const u32x4*)(Ap + (size_t)(32 * i) * lda);
#pragma unroll
      for (int i = 0; i < 4; i++) rb[i] = *(const u32x4*)(Bp + (size_t)(32 * i) * ldb);
    }
    __builtin_amdgcn_sched_barrier(0);
#pragma unroll
    for (int ks = 0; ks < 4; ks++) {
      bf16x8 af[2], bfr[2];
#pragma unroll
      for (int mt = 0; mt < 2; mt++) af[mt] = *(const bf16x8*)(sA + (wm * 64 + mt * 32 + r) * 72 + ks * 16 + hh * 8);
#pragma unroll
      for (int nt = 0; nt < 2; nt++) bfr[nt] = *(const bf16x8*)(sB + (wn * 64 + nt * 32 + r) * 72 + ks * 16 + hh * 8);
#pragma unroll
      for (int mt = 0; mt < 2; mt++)
#pragma unroll
        for (int nt = 0; nt < 2; nt++) acc[mt][nt] = MFMA(af[mt], bfr[nt], acc[mt][nt]);
    }
  }
}

DI void gemm_core_wide(const bf16_t* __restrict__ A, int lda, const bf16_t* __restrict__ Bt, int ldb, int K,
                       f32x16 (&acc)[2][4], bf16_t* sA, bf16_t* sB) {
  const int tid = tidx(), lane = tid & 63, w = tid >> 6;
  const int wm = w >> 1, wn = w & 1, r = lane & 31, hh = lane >> 5;
  const int lrow = tid >> 3, lk = (tid & 7) * 8;
  u32x4 ra[4], rb[8];
  const bf16_t* Ap = A + (size_t)lrow * lda + lk;
  const bf16_t* Bp = Bt + (size_t)lrow * ldb + lk;
#pragma unroll
  for (int i = 0; i < 4; i++) ra[i] = *(const u32x4*)(Ap + (size_t)(32 * i) * lda);
#pragma unroll
  for (int i = 0; i < 8; i++) rb[i] = *(const u32x4*)(Bp + (size_t)(32 * i) * ldb);
  const int nk = K >> 6;
  for (int kt = 0; kt < nk; kt++) {
    __syncthreads();
#pragma unroll
    for (int i = 0; i < 4; i++) *(u32x4*)(sA + (lrow + 32 * i) * 72 + lk) = ra[i];
#pragma unroll
    for (int i = 0; i < 8; i++) *(u32x4*)(sB + (lrow + 32 * i) * 72 + lk) = rb[i];
    __syncthreads();
    if (kt + 1 < nk) {
      Ap += 64;
      Bp += 64;
#pragma unroll
      for (int i = 0; i < 4; i++) ra[i] = *(const u32x4*)(Ap + (size_t)(32 * i) * lda);
#pragma unroll
      for (int i = 0; i < 8; i++) rb[i] = *(const u32x4*)(Bp + (size_t)(32 * i) * ldb);
    }
    __builtin_amdgcn_sched_barrier(0);
#pragma unroll
    for (int ks = 0; ks < 4; ks++) {
      bf16x8 af[2], bfr[4];
#pragma unroll
      for (int mt = 0; mt < 2; mt++) af[mt] = *(const bf16x8*)(sA + (wm * 64 + mt * 32 + r) * 72 + ks * 16 + hh * 8);
#pragma unroll
      for (int nt = 0; nt < 4; nt++) bfr[nt] = *(const bf16x8*)(sB + (wn * 128 + nt * 32 + r) * 72 + ks * 16 + hh * 8);
#pragma unroll
      for (int mt = 0; mt < 2; mt++)
#pragma unroll
        for (int nt = 0; nt < 4; nt++) acc[mt][nt] = MFMA(af[mt], bfr[nt], acc[mt][nt]);
    }
  }
}

DI int map_col(int maptype, int n) {
  if (maptype == 1) return n < 416 ? 4096 + n : n - 416;
  if (maptype == 2) {
    const int up = n >= FFH ? 1 : 0;
    const int j = n - up * FFH;
    return (j >> 7) * 256 + ((j >> 6) & 1) * 128 + ((j >> 5) & 1) * 64 + up * 32 + (j & 31);
  }
  return n;
}
DI void conv_tile(const float* __restrict__ src, int K, int N, int k0, int n0, bf16_t* __restrict__ dst, int maptype,
                  const float* __restrict__ rowscale, float* sT) {
  const int tid = tidx();
  __syncthreads();
#pragma unroll
  for (int i = 0; i < 4; i++) {
    const int kk = (tid >> 4) + 16 * i, nl = (tid & 15) * 4, n = n0 + nl;
    float4 v = make_float4(0.f, 0.f, 0.f, 0.f);
    if (n < N) v = *(const float4*)(src + (size_t)(k0 + kk) * N + n);
    const float sc = rowscale ? rowscale[k0 + kk] : 1.f;
    sT[kk * 65 + nl + 0] = v.x * sc;
    sT[kk * 65 + nl + 1] = v.y * sc;
    sT[kk * 65 + nl + 2] = v.z * sc;
    sT[kk * 65 + nl + 3] = v.w * sc;
  }
  __syncthreads();
#pragma unroll
  for (int i = 0; i < 2; i++) {
    const int nl = (tid >> 3) + 32 * i, k8 = (tid & 7) * 8, n = n0 + nl;
    if (n < N) {
      u32x4 u;
      u.x = pk2(sT[(k8 + 0) * 65 + nl], sT[(k8 + 1) * 65 + nl]);
      u.y = pk2(sT[(k8 + 2) * 65 + nl], sT[(k8 + 3) * 65 + nl]);
      u.z = pk2(sT[(k8 + 4) * 65 + nl], sT[(k8 + 5) * 65 + nl]);
      u.w = pk2(sT[(k8 + 6) * 65 + nl], sT[(k8 + 7) * 65 + nl]);
      *(u32x4*)(dst + (size_t)map_col(maptype, n) * K + k0 + k8) = u;
    }
  }
}
constexpr int CV_IN = 16 * 71, CV_G = 3 * 256, CV_B = 3 * 8 * 16, CV_O = 256, CV_F1 = 16 * 88, CV_F2 = 44 * 16,
              CV_UQ = 4 * 12, CV_UKV = 2 * 16;
constexpr int CV_TOTAL = CV_IN + CV_G + CV_B + CV_O + CV_F1 + CV_F2 + CV_UQ + CV_UKV + 1;
DI void conv_item(const Params& p, int layer, int it, char* smem) {
  float* sT = (float*)smem;
  if (it < CV_IN) {
    conv_tile(p.w_in + (size_t)layer * D * INW, D, INW, (it / 71) * 64, (it % 71) * 64, p.win_t, 1, nullptr, sT);
    return;
  }
  it -= CV_IN;
  if (it < CV_G) {
    const int i = it >> 8, t = it & 255;
    conv_tile(p.w_gate + ((size_t)layer * 3 + i) * D * D, D, D, (t >> 4) * 64, (t & 15) * 64, p.wg_t + (size_t)i * D * D, 0, nullptr, sT);
    return;
  }
  it -= CV_G;
  if (it < CV_B) {
    const int i = it >> 7, t = it & 127;
    conv_tile(p.w_branch + ((size_t)layer * 3 + i) * 512 * D, 512, D, (t >> 4) * 64, (t & 15) * 64, p.wb_t + (size_t)i * D * 512, 0, nullptr, sT);
    return;
  }
  it -= CV_B;
  if (it < CV_O) {
    conv_tile(p.w_o + (size_t)layer * D * D, D, D, (it >> 4) * 64, (it & 15) * 64, p.wo_t, 0, nullptr, sT);
    return;
  }
  it -= CV_O;
  if (it < CV_F1) {
    conv_tile(p.w_ff1 + (size_t)layer * D * 2 * FFH, D, 2 * FFH, (it / 88) * 64, (it % 88) * 64, p.wff1_t, 2, nullptr, sT);
    return;
  }
  it -= CV_F1;
  if (it < CV_F2) {
    conv_tile(p.w_ff2 + (size_t)layer * FFH * D, FFH, D, (it >> 4) * 64, (it & 15) * 64, p.wff2_t, 0, nullptr, sT);
    return;
  }
  it -= CV_F2;
  if (it < CV_UQ) {
    conv_tile(p.w_uq + (size_t)layer * 256 * 768, 256, 768, (it / 12) * 64, (it % 12) * 64, p.wuq_t, 0, p.qn + layer * 256, sT);
    return;
  }
  it -= CV_UQ;
  if (it < CV_UKV) {
    conv_tile(p.w_ukv + (size_t)layer * 128 * 1024, 128, 1024, (it >> 4) * 64, (it & 15) * 64, p.wukv_t, 0, p.kvn + layer * 128, sT);
    return;
  }
  u32x4 z = u32x4{0u, 0u, 0u, 0u};
  for (int e = tidx(); e < 96 * D / 8; e += 256) *(u32x4*)(p.win_t + (size_t)INW * D + (size_t)e * 8) = z;
}

DI void mod_item(const Params& p, int it, char* smem) {
  float* sC = (float*)smem;
  float* sR = sC + 5 * D;
  const int layer = it / 96, cb = it % 96;
  __syncthreads();
  for (int e = tidx(); e < 5 * D; e += 256) {
    const float v = e < 4 * D ? p.c[e] : p.c_ctx[e - 4 * D];
    sC[e] = silu_f(v);
  }
  __syncthreads();
  const int tid = tidx(), cl = tid & 63, kp = tid >> 6;
  const int n = cb * 64 + cl;
  const float* W = p.w_mod + (size_t)layer * D * 6 * D + (size_t)(kp * 256) * 6 * D + n;
  const float* cc = sC + kp * 256;
  float a0 = 0.f, a1 = 0.f, a2 = 0.f, a3 = 0.f, a4 = 0.f;
#pragma unroll 8
  for (int k = 0; k < 256; k++) {
    const float wv = W[(size_t)k * 6 * D];
    a0 += cc[k] * wv;
    a1 += cc[D + k] * wv;
    a2 += cc[2 * D + k] * wv;
    a3 += cc[3 * D + k] * wv;
    a4 += cc[4 * D + k] * wv;
  }
  sR[(kp * 5 + 0) * 64 + cl] = a0;
  sR[(kp * 5 + 1) * 64 + cl] = a1;
  sR[(kp * 5 + 2) * 64 + cl] = a2;
  sR[(kp * 5 + 3) * 64 + cl] = a3;
  sR[(kp * 5 + 4) * 64 + cl] = a4;
  __syncthreads();
  if (tid < 64) {
    const float bb = p.b_mod[layer * 6 * D + n];
    float* o = p.mod + (size_t)layer * 5 * 6 * D + n;
#pragma unroll
    for (int r = 0; r < 5; r++)
      o[(size_t)r * 6 * D] = sR[(0 * 5 + r) * 64 + tid] + sR[(1 * 5 + r) * 64 + tid] + sR[(2 * 5 + r) * 64 + tid] + sR[(3 * 5 + r) * 64 + tid] + bb;
  }
}

DI void rowpass_rows(const Params& p, bf16_t* hb, int g, int r0, int r1, int mode, int src_layer, const float* lng, const float* lnb,
                     int mod_layer, int mod_off, bool need_h) {
  const int lane = tidx() & 63, w = tidx() >> 6;
  float4 v[4], nv[4];
  if (r0 + w < r1) {
    const float* src0 = xsrc_row(p, g, src_layer, r0 + w);
#pragma unroll
    for (int j = 0; j < 4; j++) nv[j] = *(const float4*)(src0 + lane * 4 + 256 * j);
  }
#pragma unroll 1
  for (int row = r0 + w; row < r1; row += 4) {
#pragma unroll
    for (int j = 0; j < 4; j++) v[j] = nv[j];
    if (row + 4 < r1) {
      const float* srcn = xsrc_row(p, g, src_layer, row + 4);
#pragma unroll
      for (int j = 0; j < 4; j++) nv[j] = *(const float4*)(srcn + lane * 4 + 256 * j);
    }
    if (mode == 1) {
      float s = 0.f;
#pragma unroll
      for (int j = 0; j < 4; j++) s += v[j].x + v[j].y + v[j].z + v[j].w;
#pragma unroll
      for (int o = 32; o >= 1; o >>= 1) s += __shfl_xor(s, o);
      const float mu = s * (1.f / D);
      float q = 0.f;
#pragma unroll
      for (int j = 0; j < 4; j++) {
        v[j].x -= mu; v[j].y -= mu; v[j].z -= mu; v[j].w -= mu;
        q += v[j].x * v[j].x + v[j].y * v[j].y + v[j].z * v[j].z + v[j].w * v[j].w;
      }
#pragma unroll
      for (int o = 32; o >= 1; o >>= 1) q += __shfl_xor(q, o);
      const float rstd = rsqrtf(q * (1.f / D) + 1e-5f);
      float* dst = xdst_row(p, g, row);
#pragma unroll
      for (int j = 0; j < 4; j++) {
        const float4 gg = *(const float4*)(lng + lane * 4 + 256 * j);
        const float4 bb = *(const float4*)(lnb + lane * 4 + 256 * j);
        v[j].x = v[j].x * rstd * gg.x + bb.x;
        v[j].y = v[j].y * rstd * gg.y + bb.y;
        v[j].z = v[j].z * rstd * gg.z + bb.z;
        v[j].w = v[j].w * rstd * gg.w + bb.w;
        *(float4*)(dst + lane * 4 + 256 * j) = v[j];
      }
    }
    if (need_h) {
      const float* md = mod_row(p, g, mod_layer, row) + mod_off;
#pragma unroll
      for (int j = 0; j < 4; j++) {
        const float4 sh = *(const float4*)(md + lane * 4 + 256 * j);
        const float4 sc = *(const float4*)(md + D + lane * 4 + 256 * j);
        u32x2 u;
        u.x = pk2(v[j].x * (1.f + sc.x) + sh.x, v[j].y * (1.f + sc.y) + sh.y);
        u.y = pk2(v[j].z * (1.f + sc.z) + sh.z, v[j].w * (1.f + sc.w) + sh.w);
        *(u32x2*)(hb + (size_t)row * D + lane * 4 + 256 * j) = u;
      }
    }
  }
}

DI float hg_lower_bound(const Params& p, int dir, int layer, int col);
DI void inproj_item(const Params& p, const bf16_t* hb, int layer, int it, char* smem) {
  bf16_t* sA = (bf16_t*)smem;
  bf16_t* sB = sA + 128 * 72;
  int mti, nti;
  patch_decode(it, MT, 36, mti, nti);
  const int m0 = mti * 128, n0 = nti * 128;
  f32x16 acc[2][2];
#pragma unroll
  for (int a = 0; a < 2; a++)
#pragma unroll
    for (int b = 0; b < 2; b++) zero16(acc[a][b]);
  gemm_core<2>(hb + (size_t)m0 * D, D, p.win_t + (size_t)n0 * D, D, D, acc, sA, sB);
  const int lane = tidx() & 63, w = tidx() >> 6, wm = w >> 1, wn = w & 1, r = lane & 31, hh = lane >> 5;
  const int bl = m0 / LP, pb = m0 - bl * LP;
  const bool isctx = pb < CTX;
  const int seg = n0 >> 9;
  const int cw = n0 + wn * 64;
  const int rowb = m0 + wm * 64;
  if (seg == 1 || seg == 2) {
    bf16_t* dk_ = seg == 1 ? p.zf : p.zb;
    bf16_t* dg_ = seg == 1 ? p.gf : p.gb;
    const int cc = cw - seg * 512;
#pragma unroll
    for (int nt = 0; nt < 2; nt++) {
      const int col = cc + nt * 32 + r;
      const float lb = hg_lower_bound(p, seg - 1, layer, col);
#pragma unroll
      for (int mt = 0; mt < 2; mt++)
#pragma unroll
        for (int i = 0; i < 16; i++) {
          const int row = rowb + mt * 32 + crow(i, hh);
          const float z = acc[mt][nt][i];
          const float ez = __expf(-fabsf(z));
          const float ls = fminf(z, 0.f) - __logf(1.f + ez);
          const float lf = lb > 0.f ? __logf(lb + (1.f - lb) * __expf(ls)) : ls;
          const float kv = (1.f - lb) * __expf(ls - z);
          dk_[(size_t)row * 512 + col] = f2bf(kv);
          dg_[(size_t)row * 512 + col] = f2bf(lf);
        }
    }
  } else if (seg <= 4) {
    bf16_t* dst = seg == 0 ? p.hq : seg == 3 ? p.hi : p.hog;
    const int cc = cw - seg * 512;
#pragma unroll
    for (int mt = 0; mt < 2; mt++)
#pragma unroll
      for (int nt = 0; nt < 2; nt++)
#pragma unroll
        for (int i = 0; i < 16; i++) {
          const int row = rowb + mt * 32 + crow(i, hh);
          float v = acc[mt][nt][i];
          if (seg == 0) v = silu_f(v) * HG_SCALE;
          dst[(size_t)row * 512 + cc + nt * 32 + r] = f2bf(v);
        }
  } else if (seg <= 6) {
    const int cc = cw - seg * 512;
    const int hd = cc >> 7, half = (cc >> 6) & 1;
    bf16_t* dst = (seg == 5 ? p.dq : p.dk) + ((size_t)((bl * 4 + hd) * 2 + half) * LP) * 64;
    const float sc = seg == 5 ? DIFF_QSCALE : 1.f;
    const float invf = exp2f(-(float)(r & 15) * (LOG2_10000 / 16.f));
#pragma unroll
    for (int mt = 0; mt < 2; mt++)
#pragma unroll
      for (int i = 0; i < 16; i++) {
        const int pp = rowb + mt * 32 + crow(i, hh) - bl * LP;
        float x1 = acc[mt][0][i], x2 = acc[mt][1][i];
        if (!isctx) {
          const int t = pp - CTX;
          const float pos = (float)(r < 16 ? (t >> 6) : (t & 63));
          const float ang = pos * invf;
          const float cs = __cosf(ang), sn = __sinf(ang);
          const float o1 = x1 * cs - x2 * sn, o2 = x1 * sn + x2 * cs;
          x1 = o1;
          x2 = o2;
        }
        dst[(size_t)pp * 64 + r] = f2bf(x1 * sc);
        dst[(size_t)pp * 64 + 32 + r] = f2bf(x2 * sc);
      }
  } else if (seg == 7) {
    const int cc = cw - 3584;
    const int hd = cc >> 7, dvb = cc & 127;
    bf16_t* dst = p.dvt + ((size_t)(bl * 4 + hd) * 128) * LP;
#pragma unroll
    for (int mt = 0; mt < 2; mt++)
#pragma unroll
      for (int nt = 0; nt < 2; nt++)
#pragma unroll
        for (int gq = 0; gq < 4; gq++) {
          const int pp0 = rowb + mt * 32 + 8 * gq + 4 * hh - bl * LP;
          u32x2 u;
          u.x = pk2(acc[mt][nt][4 * gq + 0], acc[mt][nt][4 * gq + 1]);
          u.y = pk2(acc[mt][nt][4 * gq + 2], acc[mt][nt][4 * gq + 3]);
          *(u32x2*)(dst + (size_t)(dvb + nt * 32 + r) * LP + pp0) = u;
        }
  } else {
    const int cc = cw - 4096;
#pragma unroll
    for (int mt = 0; mt < 2; mt++)
#pragma unroll
      for (int nt = 0; nt < 2; nt++) {
        const int col = cc + nt * 32 + r;
        if (col < 416) {
#pragma unroll
          for (int i = 0; i < 16; i++) {
            const int row = rowb + mt * 32 + crow(i, hh);
            p.cbuf[(size_t)row * 416 + col] = f2bf(acc[mt][nt][i]);
          }
        }
      }
  }
}

DI void upq_item(const Params& p, int it, char* smem) {
  bf16_t* sA = (bf16_t*)smem;
  bf16_t* sB = sA + 128 * 72;
  float* sRS = (float*)(smem + 2 * 128 * 72 * 2);
  int mti, nti;
  patch_decode(it, MT, 6, mti, nti);
  const int m0 = mti * 128, n0 = nti * 128;
  const int tid = tidx();
  __syncthreads();
  {
    const int row = tid >> 1, part = tid & 1;
    const bf16_t* src = p.cbuf + (size_t)(m0 + row) * 416 + part * 128;
    float ss = 0.f;
#pragma unroll
    for (int j = 0; j < 16; j++) {
      const u32x4 u = *(const u32x4*)(src + j * 8);
      const unsigned uu[4] = {u.x, u.y, u.z, u.w};
#pragma unroll
      for (int q = 0; q < 4; q++) {
        const float a = __uint_as_float(uu[q] << 16), b = __uint_as_float(uu[q] & 0xffff0000u);
        ss += a * a + b * b;
      }
    }
    ss += __shfl_xor(ss, 1);
    if (part == 0) sRS[row] = rsqrtf(ss * (1.f / 256.f) + 1e-6f);
  }
  f32x16 acc[2][2];
#pragma unroll
  for (int a = 0; a < 2; a++)
#pragma unroll
    for (int b = 0; b < 2; b++) zero16(acc[a][b]);
  gemm_core<2>(p.cbuf + (size_t)m0 * 416, 416, p.wuq_t + (size_t)n0 * 256, 256, 256, acc, sA, sB);
  const int lane = tid & 63, w = tid >> 6, wm = w >> 1, wn = w & 1, r = lane & 31, hh = lane >> 5;
  const int bl = m0 / LP, pb = m0 - bl * LP;
  const bool isctx = pb < CTX;
  const float invf = exp2f(-(float)(r & 7) * (LOG2_10000 / 8.f));
#pragma unroll
  for (int mt = 0; mt < 2; mt++)
#pragma unroll
    for (int nt = 0; nt < 2; nt++) {
      const int nb = n0 + wn * 64 + nt * 32;
      const int hd = nb / 96, d0 = nb - hd * 96;
      const bool ispe = (d0 == 64) && !isctx;
      bf16_t* dst = p.Qm + ((size_t)(bl * 8 + hd) * LP) * 96 + d0 + r;
#pragma unroll
      for (int i = 0; i < 16; i++) {
        const int rl = wm * 64 + mt * 32 + crow(i, hh);
        const int pp = pb + rl;
        float v = acc[mt][nt][i] * sRS[rl];
        if (ispe) {
          const float pv = __shfl_xor(v, 16);
          const int t = pp - CTX;
          const float pos = (float)((r & 15) < 8 ? (t >> 6) : (t & 63));
          const float ang = pos * invf;
          const float cs = __cosf(ang), sn = __sinf(ang);
          v = (r < 16) ? (v * cs - pv * sn) : (pv * sn + v * cs);
        }
        dst[(size_t)pp * 96] = f2bf(v * MLA_QSCALE);
      }
    }
}
DI void upkv_item(const Params& p, int it, char* smem) {
  bf16_t* sA = (bf16_t*)smem;
  bf16_t* sB = sA + 128 * 72;
  float* sRS = (float*)(smem + 2 * 128 * 72 * 2);
  int mti, hd;
  patch_decode(it, MT, 8, mti, hd);
  const int m0 = mti * 128, n0 = hd * 128;
  const int tid = tidx();
  __syncthreads();
  {
    const int row = tid >> 1, part = tid & 1;
    const bf16_t* src = p.cbuf + (size_t)(m0 + row) * 416 + 256 + part * 64;
    float ss = 0.f;
#pragma unroll
    for (int j = 0; j < 8; j++) {
      const u32x4 u = *(const u32x4*)(src + j * 8);
      const unsigned uu[4] = {u.x, u.y, u.z, u.w};
#pragma unroll
      for (int q = 0; q < 4; q++) {
        const float a = __uint_as_float(uu[q] << 16), b = __uint_as_float(uu[q] & 0xffff0000u);
        ss += a * a + b * b;
      }
    }
    ss += __shfl_xor(ss, 1);
    if (part == 0) sRS[row] = rsqrtf(ss * (1.f / 128.f) + 1e-6f);
  }
  f32x16 acc[2][2];
#pragma unroll
  for (int a = 0; a < 2; a++)
#pragma unroll
    for (int b = 0; b < 2; b++) zero16(acc[a][b]);
  gemm_core<2>(p.cbuf + (size_t)m0 * 416 + 256, 416, p.wukv_t + (size_t)n0 * 128, 128, 128, acc, sA, sB);
  const int lane = tid & 63, w = tid >> 6, wm = w >> 1, wn = w & 1, r = lane & 31, hh = lane >> 5;
  const int bl = m0 / LP, pb = m0 - bl * LP;
  if (wn == 0) {
    bf16_t* dst = p.Km + ((size_t)(bl * 8 + hd) * LP) * 96;
#pragma unroll
    for (int mt = 0; mt < 2; mt++)
#pragma unroll
      for (int nt = 0; nt < 2; nt++)
#pragma unroll
        for (int i = 0; i < 16; i++) {
          const int rl = wm * 64 + mt * 32 + crow(i, hh);
          dst[(size_t)(pb + rl) * 96 + nt * 32 + r] = f2bf(acc[mt][nt][i] * sRS[rl]);
        }
  } else {
    bf16_t* dst = p.Vtm + ((size_t)(bl * 8 + hd) * 64) * LP;
#pragma unroll
    for (int mt = 0; mt < 2; mt++)
#pragma unroll
      for (int nt = 0; nt < 2; nt++)
#pragma unroll
        for (int gq = 0; gq < 4; gq++) {
          const int rl = wm * 64 + mt * 32 + 8 * gq + 4 * hh;
          u32x2 u;
          u.x = pk2(acc[mt][nt][4 * gq + 0] * sRS[rl + 0], acc[mt][nt][4 * gq + 1] * sRS[rl + 1]);
          u.y = pk2(acc[mt][nt][4 * gq + 2] * sRS[rl + 2], acc[mt][nt][4 * gq + 3] * sRS[rl + 3]);
          *(u32x2*)(dst + (size_t)(nt * 32 + r) * LP + pb + rl) = u;
        }
  }
}
DI void kpe_item(const Params& p, int it) {
  const int m0 = it * 128;
  const int tid = tidx(), row = m0 + (tid >> 1), part = tid & 1;
  const int bl = m0 / LP, pp = row - bl * LP;
  const bool isctx = pp < CTX;
  const bf16_t* src = p.cbuf + (size_t)row * 416 + 384;
#pragma unroll
  for (int jj = 0; jj < 8; jj++) {
    const int j = part * 8 + jj;
    float x1 = bf2f(src[j]), x2 = bf2f(src[j + 16]);
    if (!isctx) {
      const int t = pp - CTX;
      const float invf = exp2f(-(float)(j & 7) * (LOG2_10000 / 8.f));
      const float pos = (float)(j < 8 ? (t >> 6) : (t & 63));
      const float ang = pos * invf;
      const float cs = __cosf(ang), sn = __sinf(ang);
      const float o1 = x1 * cs - x2 * sn, o2 = x1 * sn + x2 * cs;
      x1 = o1;
      x2 = o2;
    }
    const bf16_t b1 = f2bf(x1), b2 = f2bf(x2);
#pragma unroll
    for (int hd = 0; hd < 8; hd++) {
      bf16_t* dst = p.Km + ((size_t)(bl * 8 + hd) * LP + pp) * 96 + 64;
      dst[j] = b1;
      dst[j + 16] = b2;
    }
  }
}

template <int DQK, int DV>
DI void flash_core(const bf16_t* __restrict__ Q, const bf16_t* __restrict__ Kb, const bf16_t* __restrict__ Vt, int nkt,
                   f32x16 (&O)[DV / 32], float& lsum_out, char* smem) {
  constexpr int KS = DQK + 8;
  constexpr int VS = 72;
  constexpr int KCH = 64 * DQK / 8 / 256;
  constexpr int VCH = DV * 8 / 256;
  constexpr int BUF = 64 * KS + DV * VS;
  constexpr int CPR = DQK / 8;
  bf16_t* sbase = (bf16_t*)smem;
  const int tid = tidx(), lane = tid & 63, w = tid >> 6, r = lane & 31, hh = lane >> 5;
  bf16x8 qf[DQK / 16];
  {
    const bf16_t* qp = Q + (size_t)(w * 32 + r) * DQK + hh * 8;
#pragma unroll
    for (int ks = 0; ks < DQK / 16; ks++) qf[ks] = *(const bf16x8*)(qp + ks * 16);
  }
#pragma unroll
  for (int d = 0; d < DV / 32; d++) zero16(O[d]);
  float m_run = 0.f, l_run = 0.f;
  constexpr bool NEGM = (DV <= 64);
  f32x16 negm;
  zero16(negm);
  u32x4 rk[KCH], rv[VCH];
  auto gload = [&](int kt) {
#pragma unroll
    for (int i = 0; i < KCH; i++) rk[i] = *(const u32x4*)(Kb + (size_t)kt * 64 * DQK + (size_t)(tid + 256 * i) * 8);
#pragma unroll
    for (int i = 0; i < VCH; i++) {
      const int c = tid + 256 * i;
      rv[i] = *(const u32x4*)(Vt + (size_t)(c >> 3) * LP + kt * 64 + (c & 7) * 8);
    }
  };
  auto sstore = [&](int buf) {
    bf16_t* sK = sbase + buf * BUF;
    bf16_t* sV = sK + 64 * KS;
#pragma unroll
    for (int i = 0; i < KCH; i++) {
      const int c = tid + 256 * i;
      *(u32x4*)(sK + (c / CPR) * KS + (c % CPR) * 8) = rk[i];
    }
#pragma unroll
    for (int i = 0; i < VCH; i++) {
      const int c = tid + 256 * i;
      const int q8 = c & 7;
      bf16_t* d = sV + (c >> 3) * VS + (q8 >> 1) * 16 + (q8 & 1) * 4;
      *(u32x2*)(d) = u32x2{rv[i].x, rv[i].y};
      *(u32x2*)(d + 8) = u32x2{rv[i].z, rv[i].w};
    }
  };
  __syncthreads();
  gload(0);
  sstore(0);
  __syncthreads();
  for (int kt = 0; kt < nkt; kt++) {
    const int buf = kt & 1;
    if (kt + 1 < nkt) gload(kt + 1);
    const bf16_t* sK = sbase + buf * BUF;
    const bf16_t* sV = sK + 64 * KS;
    constexpr int NKS = DQK / 16, ND = DV / 32;
    f32x16 S[2];
    {
      bf16x8 kf[2][NKS];
#pragma unroll
      for (int kb = 0; kb < 2; kb++)
#pragma unroll
        for (int ks = 0; ks < NKS; ks++) kf[kb][ks] = *(const bf16x8*)(sK + (kb * 32 + r) * KS + ks * 16 + hh * 8);
      if (NEGM) {
        S[0] = MFMA(kf[0][0], qf[0], negm);
        S[1] = MFMA(kf[1][0], qf[0], negm);
      } else {
        zero16(S[0]);
        zero16(S[1]);
        S[0] = MFMA(kf[0][0], qf[0], S[0]);
        S[1] = MFMA(kf[1][0], qf[0], S[1]);
      }
#pragma unroll
      for (int ks = 1; ks < NKS; ks++) {
        S[0] = MFMA(kf[0][ks], qf[ks], S[0]);
        S[1] = MFMA(kf[1][ks], qf[ks], S[1]);
      }
    }
    bf16x8 vfa[ND], vfb[ND];
#pragma unroll
    for (int d = 0; d < ND; d++) {
      vfa[d] = *(const bf16x8*)(sV + (d * 32 + r) * VS + 8 * hh);
    }
    float mx = S[0][0];
#pragma unroll
    for (int i = 1; i < 16; i++) mx = fmaxf(mx, S[0][i]);
#pragma unroll
    for (int i = 0; i < 16; i++) mx = fmaxf(mx, S[1][i]);
    mx = xor32_max(mx);
    if (NEGM) {
      if (kt == 0 || __builtin_amdgcn_ballot_w64(mx > 8.f) != 0) {
        const float delta = kt == 0 ? mx : fmaxf(mx, 0.f);
        const float alpha = __builtin_amdgcn_exp2f(-delta);
        m_run += delta;
        l_run *= alpha;
#pragma unroll
        for (int d = 0; d < ND; d++)
#pragma unroll
          for (int i = 0; i < 16; i++) O[d][i] *= alpha;
#pragma unroll
        for (int i = 0; i < 16; i++) {
          negm[i] = -m_run;
          S[0][i] -= delta;
          S[1][i] -= delta;
        }
      }
    } else {
      if (kt == 0 || __builtin_amdgcn_ballot_w64(mx > m_run + 8.f) != 0) {
        const float m_new = kt == 0 ? mx : fmaxf(m_run, mx);
        const float alpha = __builtin_amdgcn_exp2f(m_run - m_new);
        m_run = m_new;
        l_run *= alpha;
#pragma unroll
        for (int d = 0; d < ND; d++)
#pragma unroll
          for (int i = 0; i < 16; i++) O[d][i] *= alpha;
      }
    }
    float ls = 0.f;
#pragma unroll
    for (int kb = 0; kb < 2; kb++)
#pragma unroll
      for (int i = 0; i < 16; i++) {
        const float pv = __builtin_amdgcn_exp2f(NEGM ? S[kb][i] : S[kb][i] - m_run);
        S[kb][i] = pv;
        ls += pv;
      }
    l_run += ls;
    bf16x8 pf[2][2];
#pragma unroll
    for (int kb = 0; kb < 2; kb++)
#pragma unroll
      for (int s = 0; s < 2; s++) pf[kb][s] = pack8(S[kb], s);
#pragma unroll
    for (int gi = 0; gi < 4; gi++) {
      const int kb = gi >> 1, sx = gi & 1;
      if (gi + 1 < 4) {
        const int kb2 = (gi + 1) >> 1, s2 = (gi + 1) & 1;
#pragma unroll
        for (int d = 0; d < ND; d++) {
          const bf16x8 t = *(const bf16x8*)(sV + (d * 32 + r) * VS + kb2 * 32 + 16 * s2 + 8 * hh);
          if (gi & 1) vfa[d] = t; else vfb[d] = t;
        }
      }
#pragma unroll
      for (int d = 0; d < ND; d++) O[d] = MFMA((gi & 1) ? vfb[d] : vfa[d], pf[kb][sx], O[d]);
      }
    if (kt + 1 < nkt) sstore(buf ^ 1);
    __syncthreads();
  }
  lsum_out = l_run + __shfl_xor(l_run, 32);
}

DI void mla_item(const Params& p, int hb, int qt, char* smem) {
  const int bl = hb >> 3, hd = hb & 7;
  const int nkt = qt < 2 ? CTX / 64 : LP / 64;
  f32x16 O[2];
  float l;
  flash_core<96, 64>(p.Qm + ((size_t)hb * LP + qt * 128) * 96, p.Km + (size_t)hb * LP * 96, p.Vtm + (size_t)hb * 64 * LP, nkt, O, l, smem);
  const int lane = tidx() & 63, w = tidx() >> 6, r = lane & 31, hh = lane >> 5;
  const float inv = 1.f / l;
  bf16_t* dst = p.ymla + ((size_t)(bl * LP + qt * 128 + w * 32 + r)) * 512 + hd * 64;
#pragma unroll
  for (int d = 0; d < 2; d++)
#pragma unroll
    for (int gq = 0; gq < 4; gq++) {
      u32x2 u;
      u.x = pk2(O[d][4 * gq + 0] * inv, O[d][4 * gq + 1] * inv);
      u.y = pk2(O[d][4 * gq + 2] * inv, O[d][4 * gq + 3] * inv);
      *(u32x2*)(dst + d * 32 + 8 * gq + 4 * hh) = u;
    }
}

DI void diff_item(const Params& p, int layer, float lam_init, int hb, int qt, char* smem) {
  const int bl = hb >> 2, hd = hb & 3;
  const int nkt = qt < 2 ? CTX / 64 : LP / 64;
  const int tid = tidx(), lane = tid & 63, w = tid >> 6, r = lane & 31, hh = lane >> 5;
  const float* dl = p.diff_lambda + layer * 256;
  float s1 = 0.f, s2 = 0.f;
  for (int j = 0; j < 64; j++) {
    s1 += dl[j] * dl[64 + j];
    s2 += dl[128 + j] * dl[192 + j];
  }
  const float lam = expf(s1) - expf(s2) + lam_init;
  float4* st = (float4*)(p.stash + ((size_t)blockIdx.x * 256 + tid) * 64);
  f32x16 O[4];
  float l;
  flash_core<64, 128>(p.dq + ((size_t)(hb * 2 + 0) * LP + qt * 128) * 64, p.dk + (size_t)(hb * 2 + 0) * LP * 64,
                      p.dvt + (size_t)hb * 128 * LP, nkt, O, l, smem);
  {
    const float inv = 1.f / l;
#pragma unroll
    for (int d = 0; d < 4; d++)
#pragma unroll
      for (int gq = 0; gq < 4; gq++)
        st[d * 4 + gq] = make_float4(O[d][4 * gq] * inv, O[d][4 * gq + 1] * inv, O[d][4 * gq + 2] * inv, O[d][4 * gq + 3] * inv);
  }
  flash_core<64, 128>(p.dq + ((size_t)(hb * 2 + 1) * LP + qt * 128) * 64, p.dk + (size_t)(hb * 2 + 1) * LP * 64,
                      p.dvt + (size_t)hb * 128 * LP, nkt, O, l, smem);
  const float inv2 = lam / l;
  float ss = 0.f;
#pragma unroll
  for (int d = 0; d < 4; d++)
#pragma unroll
    for (int gq = 0; gq < 4; gq++) {
      const float4 sv = st[d * 4 + gq];
      const float o0 = sv.x - O[d][4 * gq + 0] * inv2, o1 = sv.y - O[d][4 * gq + 1] * inv2;
      const float o2 = sv.z - O[d][4 * gq + 2] * inv2, o3 = sv.w - O[d][4 * gq + 3] * inv2;
      O[d][4 * gq + 0] = o0; O[d][4 * gq + 1] = o1; O[d][4 * gq + 2] = o2; O[d][4 * gq + 3] = o3;
      ss += o0 * o0 + o1 * o1 + o2 * o2 + o3 * o3;
    }
  ss += __shfl_xor(ss, 32);
  const float rs = rsqrtf(ss * (1.f / 128.f) + 1e-6f) * (1.f - lam_init);
  const float* sub = p.diff_subln + layer * 128;
  bf16_t* dst = p.ydiff + ((size_t)(bl * LP + qt * 128 + w * 32 + r)) * 512 + hd * 128;
#pragma unroll
  for (int d = 0; d < 4; d++)
#pragma unroll
    for (int gq = 0; gq < 4; gq++) {
      const int dv = d * 32 + 8 * gq + 4 * hh;
      const float4 sg = *(const float4*)(sub + dv);
      u32x2 u;
      u.x = pk2(O[d][4 * gq + 0] * rs * sg.x, O[d][4 * gq + 1] * rs * sg.y);
      u.y = pk2(O[d][4 * gq + 2] * rs * sg.z, O[d][4 * gq + 3] * rs * sg.w);
      *(u32x2*)(dst + dv) = u;
    }
}

constexpr int HQS = 136, HTS = 40;
struct HgLds {
  bf16_t *sQ, *sK, *sKT, *sVT;
  float *sER, *sA1, *sA2, *sTot;
};
DI HgLds hg_lds(char* smem) {
  HgLds L;
  L.sQ = (bf16_t*)smem;
  L.sK = L.sQ + 32 * HQS;
  L.sKT = L.sK + 32 * HQS;
  L.sVT = L.sKT + 128 * HTS;
  L.sER = (float*)(L.sVT + 128 * HTS);
  L.sA1 = L.sER + 128;
  L.sA2 = L.sA1 + 128;
  L.sTot = L.sA2 + 128;
  return L;
}
DI float hg_lower_bound(const Params& p, int dir, int layer, int col) {
  const float* lg = p.lb_logits + (size_t)dir * DEPTH * 512 + col;
  const float v0 = lg[0], v1 = lg[512], v2 = lg[1024], v3 = lg[1536];
  const float mx = fmaxf(fmaxf(v0, v1), fmaxf(v2, v3));
  const float e0 = expf(v0 - mx), e1 = expf(v1 - mx), e2 = expf(v2 - mx), e3 = expf(v3 - mx);
  const float inv = 1.f / (e0 + e1 + e2 + e3);
  float acc = 0.f;
  if (layer >= 1) acc += e1;
  if (layer >= 2) acc += e2;
  if (layer >= 3) acc += e3;
  return acc * inv;
}
DI float hg_stage(const Params& p, const HgLds& L, int dir, int hd, size_t row0, int rstep) {
  const int tid = tidx(), k = tid & 127, half = tid >> 7;
  const size_t cofs = hd * 128 + k;
  const bf16_t* gsrc = (dir ? p.gb : p.gf) + cofs;
  const bf16_t* ksrc = (dir ? p.zb : p.zf) + cofs;
  float bc[16];
  unsigned kq[16];
  bf16_t vr[16];
  float cum = 0.f;
#pragma unroll
  for (int uu = 0; uu < 16; uu++) {
    const int u = half * 16 + uu;
    const size_t row = row0 + (size_t)((long)rstep * u);
    const float gl = bf2f(gsrc[row * 512]);
    kq[uu] = (unsigned)ksrc[row * 512] | ((unsigned)p.hq[row * 512 + cofs] << 16);
    vr[uu] = p.hi[row * 512 + cofs];
    cum += gl;
    bc[uu] = cum;
  }
  __syncthreads();
  if (half == 0) L.sTot[k] = cum;
  __syncthreads();
  const float rref = L.sTot[k];
  float blast = 0.f;
  if (half == 1) {
    blast = rref + cum;
    L.sER[k] = __expf(rref);
    L.sA1[k] = __expf(blast);
    L.sA2[k] = __expf(blast - rref);
  }
  const float off = half ? 0.f : -rref;
#pragma unroll
  for (int uu = 0; uu < 16; uu++) {
    const int u = half * 16 + uu;
    const float e = fminf(fmaxf(bc[uu] + off, -80.f), 80.f);
    const float kvv = __uint_as_float(kq[uu] << 16);
    const float q = __uint_as_float(kq[uu] & 0xffff0000u);
    const float ee = __expf(e);
    const bf16_t kt = f2bf(kvv * __frcp_rn(ee));
    L.sQ[u * HQS + k] = f2bf(q * ee);
    L.sK[u * HQS + k] = kt;
    L.sKT[k * HTS + u] = kt;
    L.sVT[k * HTS + u] = vr[uu];
    if ((uu & 3) == 3) __builtin_amdgcn_sched_barrier(0);
  }
  __syncthreads();
  return blast;
}
DI void hg_update(const HgLds& L, f32x16 (&S)[4]) {
  const int lane = tidx() & 63, w = tidx() >> 6, r = lane & 31, hh = lane >> 5;
#pragma unroll
  for (int dkt = 0; dkt < 4; dkt++) {
    f32x16 T;
    zero16(T);
#pragma unroll
    for (int st = 0; st < 2; st++) {
      const bf16x8 a = *(const bf16x8*)(L.sKT + (dkt * 32 + r) * HTS + st * 16 + 8 * hh);
      const bf16x8 b = *(const bf16x8*)(L.sVT + (w * 32 + r) * HTS + st * 16 + 8 * hh);
      T = MFMA(a, b, T);
    }
#pragma unroll
    for (int gq = 0; gq < 4; gq++) {
      const int dk = dkt * 32 + 8 * gq + 4 * hh;
      const float4 a1 = *(const float4*)(L.sA1 + dk);
      const float4 a2 = *(const float4*)(L.sA2 + dk);
      S[dkt][4 * gq + 0] = a1.x * S[dkt][4 * gq + 0] + a2.x * T[4 * gq + 0];
      S[dkt][4 * gq + 1] = a1.y * S[dkt][4 * gq + 1] + a2.y * T[4 * gq + 1];
      S[dkt][4 * gq + 2] = a1.z * S[dkt][4 * gq + 2] + a2.z * T[4 * gq + 2];
      S[dkt][4 * gq + 3] = a1.w * S[dkt][4 * gq + 3] + a2.w * T[4 * gq + 3];
    }
  }
}
DI void hg_output(const HgLds& L, const f32x16 (&S)[4], f32x16& O) {
  const int lane = tidx() & 63, w = tidx() >> 6, r = lane & 31, hh = lane >> 5;
  f32x16 X;
  zero16(X);
#pragma unroll
  for (int ks = 0; ks < 8; ks++) {
    const bf16x8 a = *(const bf16x8*)(L.sK + r * HQS + ks * 16 + 8 * hh);
    const bf16x8 b = *(const bf16x8*)(L.sQ + r * HQS + ks * 16 + 8 * hh);
    X = MFMA(a, b, X);
  }
#pragma unroll
  for (int i = 0; i < 16; i++)
    if (crow(i, hh) > r) X[i] = 0.f;
  zero16(O);
#pragma unroll
  for (int st = 0; st < 2; st++) {
    const bf16x8 pf = pack8(X, st);
    const bf16_t* vp = L.sVT + (w * 32 + r) * HTS + 16 * st + 4 * hh;
    const bf16x8 vf = cat4(*(const bf16x4*)vp, *(const bf16x4*)(vp + 8));
    O = MFMA(vf, pf, O);
  }
#pragma unroll
  for (int dkt = 0; dkt < 4; dkt++) {
    f32x16 Ss;
#pragma unroll
    for (int gq = 0; gq < 4; gq++) {
      const float4 er = *(const float4*)(L.sER + dkt * 32 + 8 * gq + 4 * hh);
      Ss[4 * gq + 0] = S[dkt][4 * gq + 0] * er.x;
      Ss[4 * gq + 1] = S[dkt][4 * gq + 1] * er.y;
      Ss[4 * gq + 2] = S[dkt][4 * gq + 2] * er.z;
      Ss[4 * gq + 3] = S[dkt][4 * gq + 3] * er.w;
    }
#pragma unroll
    for (int st = 0; st < 2; st++) {
      const bf16x8 xs = pack8(Ss, st);
      const bf16_t* qp = L.sQ + r * HQS + dkt * 32 + 16 * st + 4 * hh;
      const bf16x8 qb = cat4(*(const bf16x4*)qp, *(const bf16x4*)(qp + 8));
      O = MFMA(xs, qb, O);
    }
  }
}
DI int hg_pos(int dir, int rng) { return dir == 0 ? rng : (rng == 0 ? 0 : NRNG - rng); }

DI void hg1_item(const Params& p, int layer, int sq, int rng, char* smem) {
  const HgLds L = hg_lds(smem);
  const int dir = sq & 1, hd = (sq >> 1) & 3, bl = sq >> 3;
  const int tid = tidx(), lane = tid & 63, w = tid >> 6, r = lane & 31, hh = lane >> 5;
  f32x16 S[4];
#pragma unroll
  for (int i = 0; i < 4; i++) zero16(S[i]);
  float btot = 0.f;
  const size_t rbase = (size_t)bl * LP + rng * 256;
  for (int c = 0; c < 8; c++) {
    const size_t row0 = dir ? rbase + 255 - c * 32 : rbase + c * 32;
    btot += hg_stage(p, L, dir, hd, row0, dir ? -1 : 1);
    hg_update(L, S);
  }
  const int pos = hg_pos(dir, rng);
  float* dst = p.hgst + ((size_t)sq * NRNG + pos) * 16384;
#pragma unroll
  for (int dkt = 0; dkt < 4; dkt++)
#pragma unroll
    for (int i = 0; i < 16; i++) dst[(dkt * 32 + crow(i, hh)) * 128 + w * 32 + r] = S[dkt][i];
  if (tid >= 128) p.hgdec[((size_t)sq * NRNG + pos) * 128 + (tid & 127)] = __expf(btot);
}
DI void hg2_item(const Params& p, int sq, int sl) {
  const int e = sl * 256 + tidx();
  const int dk = e >> 7;
  float* base = p.hgst + (size_t)sq * NRNG * 16384 + e;
  const float* dec = p.hgdec + (size_t)sq * NRNG * 128 + dk;
  float u[NRNG], dcy[NRNG];
#pragma unroll
  for (int pos = 0; pos < NRNG; pos++) {
    u[pos] = base[(size_t)pos * 16384];
    dcy[pos] = dec[pos * 128];
  }
  float S = 0.f;
#pragma unroll
  for (int pos = 0; pos < NRNG; pos++) {
    const float o = S;
    S = dcy[pos] * S + u[pos];
    u[pos] = o;
  }
#pragma unroll
  for (int pos = 0; pos < NRNG; pos++) base[(size_t)pos * 16384] = u[pos];
}
DI void hg3_item(const Params& p, int layer, int bh, int rng, char* smem) {
  const HgLds L = hg_lds(smem);
  const int hd = bh & 3, bl = bh >> 2;
  const int tid = tidx(), lane = tid & 63, w = tid >> 6, r = lane & 31, hh = lane >> 5;
  const size_t rbase = (size_t)bl * LP + rng * 256;
#pragma unroll 1
  for (int dir = 0; dir < 2; dir++) {
    const int sq = bh * 2 + dir;
    const int pos = hg_pos(dir, rng);
    const float* src = p.hgst + ((size_t)sq * NRNG + pos) * 16384;
    f32x16 S[4];
#pragma unroll
    for (int dkt = 0; dkt < 4; dkt++)
#pragma unroll
      for (int i = 0; i < 16; i++) S[dkt][i] = src[(dkt * 32 + crow(i, hh)) * 128 + w * 32 + r];
    if (dir == 1) __syncthreads();
#pragma unroll 1
    for (int c = 0; c < 8; c++) {
      const size_t row0 = dir ? rbase + 255 - c * 32 : rbase + c * 32;
      const size_t trow = dir ? row0 - r : row0 + r;
      float* od = p.osum + trow * 512 + hd * 128 + w * 32;
      float4 prev[4];
      if (dir == 1) {
#pragma unroll
        for (int gq = 0; gq < 4; gq++) prev[gq] = *(const float4*)(od + 8 * gq + 4 * hh);
      }
      hg_stage(p, L, dir, hd, row0, dir ? -1 : 1);
      f32x16 O;
      hg_output(L, S, O);
#pragma unroll
      for (int gq = 0; gq < 4; gq++) {
        float4 v = make_float4(O[4 * gq + 0], O[4 * gq + 1], O[4 * gq + 2], O[4 * gq + 3]);
        if (dir == 1) {
          v.x += prev[gq].x; v.y += prev[gq].y; v.z += prev[gq].z; v.w += prev[gq].w;
        }
        *(float4*)(od + 8 * gq + 4 * hh) = v;
      }
      if (c < 7) hg_update(L, S);
    }
  }
  __syncthreads();
  const float* gn = p.hg_norm + layer * 128;
  const float g0 = gn[2 * lane], g1 = gn[2 * lane + 1];
#pragma unroll 1
  for (int t0 = w; t0 < 256; t0 += 32) {
    float2 v[8];
    unsigned og[8];
#pragma unroll
    for (int q = 0; q < 8; q++) {
      const size_t row = rbase + t0 + 4 * q;
      v[q] = *(const float2*)(p.osum + row * 512 + hd * 128 + 2 * lane);
      og[q] = *(const unsigned*)(p.hog + row * 512 + hd * 128 + 2 * lane);
    }
#pragma unroll
    for (int q = 0; q < 8; q++) {
      const size_t row = rbase + t0 + 4 * q;
      float ss = v[q].x * v[q].x + v[q].y * v[q].y;
#pragma unroll
      for (int o = 32; o >= 1; o >>= 1) ss += __shfl_xor(ss, o);
      const float rs = rsqrtf(ss * (1.f / 128.f) + 1e-6f);
      const float o0 = __uint_as_float(og[q] << 16), o1 = __uint_as_float(og[q] & 0xffff0000u);
      *(unsigned*)(p.yhg + row * 512 + hd * 128 + 2 * lane) = pk2(v[q].x * rs * g0 * silu_f(o0), v[q].y * rs * g1 * silu_f(o1));
    }
  }
}

constexpr int MERGE_FULL = 1024, MERGE_ITEMS = MERGE_FULL + 64;
DI void merge_half_item(const Params& p, const bf16_t* hb, int layer, int mti, int nti, char* smem) {

  bf16_t* sA = (bf16_t*)smem;
  bf16_t* sB = sA + 128 * 72;
  const int m0 = mti * 128, n0 = nti * 64;
  const int lane = tidx() & 63, w = tidx() >> 6, wm = w >> 1, wn = w & 1, r = lane & 31, hh = lane >> 5;
  f32x16 mac[2];
  zero16(mac[0]);
  zero16(mac[1]);
  const int col = n0 + wn * 32 + r;
#pragma unroll 1
  for (int i = 0; i < 3; i++) {
    f32x16 ga[2][1], ba[2][1];
    zero16(ga[0][0]);
    zero16(ga[1][0]);
    gemm_core<1>(hb + (size_t)m0 * D, D, p.wg_t + ((size_t)i * D + n0) * D, D, D, ga, sA, sB);
    const float bg = p.b_gate[(layer * 3 + i) * D + col];
#pragma unroll
    for (int mt = 0; mt < 2; mt++)
#pragma unroll
      for (int j = 0; j < 16; j++) ga[mt][0][j] = sigmoid_f(ga[mt][0][j] + bg);
    zero16(ba[0][0]);
    zero16(ba[1][0]);
    const bf16_t* Y = i == 0 ? p.ymla : i == 1 ? p.yhg : p.ydiff;
    gemm_core<1>(Y + (size_t)m0 * 512, 512, p.wb_t + ((size_t)i * D + n0) * 512, 512, 512, ba, sA, sB);
#pragma unroll
    for (int mt = 0; mt < 2; mt++)
#pragma unroll
      for (int j = 0; j < 16; j++) mac[mt][j] += ga[mt][0][j] * ba[mt][0][j];
  }
#pragma unroll
  for (int mt = 0; mt < 2; mt++)
#pragma unroll
    for (int j = 0; j < 16; j++) {
      const int row = m0 + wm * 64 + mt * 32 + crow(j, hh);
      p.mbuf[(size_t)row * D + col] = f2bf(mac[mt][j]);
    }
}

DI void merge_item(const Params& p, const bf16_t* hb, int layer, int it, char* smem) {
  bf16_t* sA = (bf16_t*)smem;
  bf16_t* sB = sA + 128 * 72;
  int mti, nti;
  if (it >= MERGE_FULL) {
    patch_decode(MERGE_FULL + ((it - MERGE_FULL) >> 1), MT, 8, mti, nti);
    merge_half_item(p, hb, layer, mti, nti * 2 + ((it - MERGE_FULL) & 1), smem);
    return;
  }
  patch_decode(it, MT, 8, mti, nti);
  const int m0 = mti * 128, n0 = nti * 128;
  const int lane = tidx() & 63, w = tidx() >> 6, wm = w >> 1, wn = w & 1, r = lane & 31, hh = lane >> 5;
  unsigned mpk[2][2][8];
#pragma unroll
  for (int a = 0; a < 2; a++)
#pragma unroll
    for (int b = 0; b < 2; b++)
#pragma unroll
      for (int j = 0; j < 8; j++) mpk[a][b][j] = 0u;
#pragma unroll 1
  for (int i = 0; i < 3; i++) {
    unsigned gpk[2][2][8];
    {
      f32x16 ga[2][2];
#pragma unroll
      for (int a = 0; a < 2; a++)
#pragma unroll
        for (int b = 0; b < 2; b++) zero16(ga[a][b]);
      gemm_core1(hb + (size_t)m0 * D, D, p.wg_t + ((size_t)i * D + n0) * D, D, D, ga, sA, sB);
#pragma unroll
      for (int nt = 0; nt < 2; nt++) {
        const float bg = p.b_gate[(layer * 3 + i) * D + n0 + wn * 64 + nt * 32 + r];
#pragma unroll
        for (int mt = 0; mt < 2; mt++)
#pragma unroll
          for (int j = 0; j < 8; j++)
            gpk[mt][nt][j] = pk2(sigmoid_f(ga[mt][nt][2 * j] + bg), sigmoid_f(ga[mt][nt][2 * j + 1] + bg));
      }
    }
    f32x16 ba[2][2];
#pragma unroll
    for (int a = 0; a < 2; a++)
#pragma unroll
      for (int b = 0; b < 2; b++) zero16(ba[a][b]);
    const bf16_t* Y = i == 0 ? p.ymla : i == 1 ? p.yhg : p.ydiff;
    gemm_core1(Y + (size_t)m0 * 512, 512, p.wb_t + ((size_t)i * D + n0) * 512, 512, 512, ba, sA, sB);
#pragma unroll
    for (int mt = 0; mt < 2; mt++)
#pragma unroll
      for (int nt = 0; nt < 2; nt++)
#pragma unroll
        for (int j = 0; j < 8; j++) {
          const unsigned u = gpk[mt][nt][j], m = mpk[mt][nt][j];
          const float lo = __uint_as_float(m << 16) + __uint_as_float(u << 16) * ba[mt][nt][2 * j];
          const float hi = __uint_as_float(m & 0xffff0000u) + __uint_as_float(u & 0xffff0000u) * ba[mt][nt][2 * j + 1];
          mpk[mt][nt][j] = pk2(lo, hi);
        }
  }
#pragma unroll
  for (int mt = 0; mt < 2; mt++)
#pragma unroll
    for (int nt = 0; nt < 2; nt++)
#pragma unroll
      for (int j = 0; j < 16; j++) {
        const int row = m0 + wm * 64 + mt * 32 + crow(j, hh);
        const unsigned m = mpk[mt][nt][j >> 1];
        p.mbuf[(size_t)row * D + n0 + wn * 64 + nt * 32 + r] = (bf16_t)((j & 1) ? (m >> 16) : (m & 0xffffu));
      }
}

constexpr int RES_FULL = 1024, RES_ITEMS = RES_FULL + 64;
DI void resid_item(const Params& p, int g, int layer, int it, const bf16_t* A, int K, const bf16_t* Wt, int gate_off,
                   char* smem) {
  bf16_t* sA = (bf16_t*)smem;
  bf16_t* sB = sA + 128 * 72;
  const int lane = tidx() & 63, w = tidx() >> 6, wm = w >> 1, wn = w & 1, r = lane & 31, hh = lane >> 5;
  if (it >= RES_FULL) {
    int mti, nti;
    patch_decode(RES_FULL + ((it - RES_FULL) >> 1), MT, 8, mti, nti);
    const int m0 = mti * 128, n0 = nti * 128 + ((it - RES_FULL) & 1) * 64;
    f32x16 acc[2][1];
    zero16(acc[0][0]);
    zero16(acc[1][0]);
    gemm_core<1>(A + (size_t)m0 * K, K, Wt + (size_t)n0 * K, K, K, acc, sA, sB);
    const float* md = mod_row(p, g, layer, m0) + gate_off;
    const float* xs = xsrc_row(p, g, gate_off == 2 * D ? layer : 1, m0);
    float* xd = xdst_row(p, g, m0);
    const int col = n0 + wn * 32 + r;
    const float gt = md[col];
#pragma unroll
    for (int mt = 0; mt < 2; mt++) {
#pragma unroll
      for (int i = 0; i < 16; i++) {
        const int ro = (wm * 64 + mt * 32 + crow(i, hh)) * D + col;
        xd[ro] = ALPHA * xs[ro] + gt * acc[mt][0][i];
      }
      __builtin_amdgcn_sched_barrier(0);
    }
    return;
  }
  int mti, nti;
  patch_decode(it, MT, 8, mti, nti);
  const int m0 = mti * 128, n0 = nti * 128;
  f32x16 acc[2][2];
#pragma unroll
  for (int a = 0; a < 2; a++)
#pragma unroll
    for (int b = 0; b < 2; b++) zero16(acc[a][b]);
  gemm_core<2>(A + (size_t)m0 * K, K, Wt + (size_t)n0 * K, K, K, acc, sA, sB);
  const float* md = mod_row(p, g, layer, m0) + gate_off;
  const float* xs = xsrc_row(p, g, gate_off == 2 * D ? layer : 1, m0);
  float* xd = xdst_row(p, g, m0);
#pragma unroll
  for (int nt = 0; nt < 2; nt++) {
    const int col = n0 + wn * 64 + nt * 32 + r;
    const float gt = md[col];
#pragma unroll
    for (int mt = 0; mt < 2; mt++) {
#pragma unroll
      for (int i = 0; i < 16; i++) {
        const int ro = (wm * 64 + mt * 32 + crow(i, hh)) * D + col;
        xd[ro] = ALPHA * xs[ro] + gt * acc[mt][nt][i];
      }
      __builtin_amdgcn_sched_barrier(0);
    }
  }
}

DI void ffn1_item(const Params& p, const bf16_t* hb, int it, char* smem) {
  bf16_t* sA = (bf16_t*)smem;
  bf16_t* sB = sA + 128 * 72;
  int mti, nti;
  patch_decode(it, MT, 22, mti, nti);
  const int m0 = mti * 128, n0 = nti * 256;
  f32x16 acc[2][4];
#pragma unroll
  for (int a = 0; a < 2; a++)
#pragma unroll
    for (int b = 0; b < 4; b++) zero16(acc[a][b]);
  gemm_core_wide(hb + (size_t)m0 * D, D, p.wff1_t + (size_t)n0 * D, D, D, acc, sA, sB);
  const int lane = tidx() & 63, w = tidx() >> 6, wm = w >> 1, wn = w & 1, r = lane & 31, hh = lane >> 5;
#pragma unroll
  for (int pr = 0; pr < 2; pr++) {
    const int col = nti * 128 + wn * 64 + pr * 32 + r;
#pragma unroll
    for (int mt = 0; mt < 2; mt++)
#pragma unroll
      for (int i = 0; i < 16; i++) {
        const int row = m0 + wm * 64 + mt * 32 + crow(i, hh);
        p.hid[(size_t)row * FFH + col] = f2bf(silu_f(acc[mt][2 * pr][i]) * acc[mt][2 * pr + 1][i]);
      }
  }
}

#define XCD_LOOP(N, L)                                                     \
  for (int k_ = 0, nb8_ = nblk >> 3; k_ * 8 * nb8_ < (N); k_++)            \
    for (int L = (k_ * 8 + (bid & 7)) * nb8_ + (bid >> 3), o_ = 1; o_ && L < (N); o_ = 0)
#define XCD_LOOP_SPREAD(N, L)                                                                          \
  for (int ph_ = 0, nf_ = ((N) / nblk) * nblk; ph_ < 2; ph_++)                                          \
    for (int k_ = 0, nb8_ = nblk >> 3; ph_ == 0 ? (k_ * 8 * nb8_ < nf_) : (k_ == 0); k_++)              \
      for (int L = ph_ == 0 ? (k_ * 8 + (bid & 7)) * nb8_ + (bid >> 3) : nf_ + bid, o_ = 1;             \
           o_ && L < (ph_ == 0 ? nf_ : (N)); o_ = 0)
#define XB_TMO      128
#define XB_XCNT(j)  (256  + 64 * (j))
#define XB_XSUB(j)  (1280 + 64 * (j))
#define XB_XGEN(j)  (2304 + 64 * (j))
#define XB_TOP      3328
#define XB_TOPGEN   3392
#define XCD_BAR_WORDS 3456
#define XB_SPIN_CAP (1u << 20)
#define LAS __attribute__((address_space(3)))
DI unsigned xb_ld(unsigned* p) { return __hip_atomic_load(p, __ATOMIC_RELAXED, __HIP_MEMORY_SCOPE_AGENT); }
DI unsigned xb_add(unsigned* p, unsigned v) { return __hip_atomic_fetch_add(p, v, __ATOMIC_RELAXED, __HIP_MEMORY_SCOPE_AGENT); }
DI unsigned xb_xcc_id() { return (unsigned)__builtin_amdgcn_s_getreg((3 << 11) | 20) & 0xFu; }
#define XB_SPIN(cond, bar) do { unsigned _sp = 0; while (cond) { __builtin_amdgcn_s_sleep(1); \
    if ((++_sp & 255u) == 0u) { if (xb_ld(&(bar)[XB_TMO])) break; if (_sp > XB_SPIN_CAP) { atomicAdd(&(bar)[XB_TMO], 1u); break; } } } } while (0)
struct XcdBarrier {
  unsigned* bar;
  unsigned x;
  volatile LAS unsigned* st;
};
DI XcdBarrier xcd_barrier_post(unsigned* bar, volatile LAS unsigned* st) {
  XcdBarrier b;
  b.bar = bar;
  b.x = xb_xcc_id();
  b.st = st;
  if (threadIdx.x == 0) (void)xb_add(&bar[XB_XCNT(b.x)], 1u);
  return b;
}
DI void xcd_barrier_complete(unsigned* bar, unsigned x, unsigned& nloc, unsigned& nx) {
  const unsigned G = gridDim.x * gridDim.y * gridDim.z;
  unsigned sum, cnt, mine, sp = 0u;
  for (;;) {
    sum = 0u; cnt = 0u; mine = 0u;
#pragma unroll
    for (unsigned j = 0; j < 16; ++j) {
      const unsigned c = xb_ld(&bar[XB_XCNT(j)]);
      sum += c;
      cnt += (c > 0u) ? 1u : 0u;
      mine = (j == x) ? c : mine;
    }
    if (sum == G) break;
    __builtin_amdgcn_s_sleep(1);
    if ((++sp & 255u) == 0u) {
      if (xb_ld(&bar[XB_TMO])) break;
      if (sp > XB_SPIN_CAP) { atomicAdd(&bar[XB_TMO], 1u); break; }
    }
  }
  nloc = mine > 0u ? mine : 1u;
  nx = cnt > 0u ? cnt : 1u;
}
DI void xcd_barrier(const XcdBarrier& b) {
  asm volatile("s_waitcnt vmcnt(0)" ::: "memory");
  __syncthreads();
  if (threadIdx.x == 0) {
    unsigned* bar = b.bar;
    __builtin_amdgcn_s_waitcnt(0);
    unsigned nloc = b.st[0], nx = b.st[1];
    if (nloc == 0u) {
      xcd_barrier_complete(bar, b.x, nloc, nx);
      b.st[0] = nloc;
      b.st[1] = nx;
    }
    const unsigned old = xb_add(&bar[XB_XSUB(b.x)], 1u);
    const unsigned gen = old / nloc;
    if (old + 1u == (gen + 1u) * nloc) {
      __builtin_amdgcn_fence(__ATOMIC_RELEASE, "agent");
      asm volatile("s_waitcnt vmcnt(0)" ::: "memory");
      const unsigned og = xb_add(&bar[XB_TOP], 1u);
      const unsigned tg = og / nx;
      if (og + 1u == (tg + 1u) * nx) xb_add(&bar[XB_TOPGEN], 1u);
      else XB_SPIN(xb_ld(&bar[XB_TOPGEN]) == tg, bar);
      __builtin_amdgcn_fence(__ATOMIC_ACQUIRE, "agent");
      xb_add(&bar[XB_XGEN(b.x)], 1u);
      asm volatile("s_waitcnt vmcnt(0)" ::: "memory");
    } else {
      XB_SPIN(xb_ld(&bar[XB_XGEN(b.x)]) == gen, bar);
      __builtin_amdgcn_fence(__ATOMIC_ACQUIRE, "agent");
      asm volatile("s_waitcnt vmcnt(0)" ::: "memory");
    }
  }
  __syncthreads();
}

DI void dep_publish(unsigned* c1, unsigned* c2) {
  asm volatile("s_waitcnt vmcnt(0)" ::: "memory");
  __syncthreads();
  if (threadIdx.x == 0) {
    __builtin_amdgcn_fence(__ATOMIC_RELEASE, "agent");
    asm volatile("s_waitcnt vmcnt(0)" ::: "memory");
    xb_add(c1, 1u);
    if (c2) xb_add(c2, 1u);
  }
}
DI void dep_wait(unsigned* c, unsigned target, unsigned* bar) {
  if (threadIdx.x == 0) {
    XB_SPIN(xb_ld(c) < target, bar);
    __builtin_amdgcn_fence(__ATOMIC_ACQUIRE, "agent");
    asm volatile("s_waitcnt vmcnt(0)" ::: "memory");
  }
  __syncthreads();
}

__global__ void __launch_bounds__(256, 2) mega_kernel(Params p, float li0, float li1, float li2, float li3, int repD, int repG, int repH) {
  __shared__ __attribute__((aligned(16))) char smem[SMEM_BYTES];
  cg::grid_group grid = cg::this_grid();
  const int nblk = gridDim.x, bid = blockIdx.x;
  __shared__ uint4 xb_words;
  if (threadIdx.x == 0) xb_words = make_uint4(0u, 0u, 0u, 0u);
  if (bid == 0) {
    for (int e = tidx(); e < XCD_BAR_WORDS; e += 256) p.xbar[e] = 0u;
    for (int e = tidx(); e < NGRP * DEPTH * 512; e += 256) p.dep[e] = 0u;
    p.qctr[tidx()] = 0u;
  }
  __syncthreads();
  for (int it = bid; it < 384 + CV_TOTAL; it += nblk) {
    if (it < 384) mod_item(p, it, smem);
    else conv_item(p, 0, it - 384, smem);
  }
  grid.sync();
  const XcdBarrier xb = xcd_barrier_post(p.xbar, (volatile LAS unsigned*)&xb_words);
  const int rpb = (TG + nblk - 1) / nblk;
  const int rp0 = min(TG, bid * rpb), rp1 = min(TG, rp0 + rpb);
#pragma unroll 1
  for (int g = 0; g < NGRP; g++) {
    rowpass_rows(p, p.h + (size_t)g * TG * D, g, rp0, rp1, 0, 0, nullptr, nullptr, 0, 0, true);
  }
  xcd_barrier(xb);
#pragma unroll 1
  for (int layer = 0; layer < DEPTH; layer++) {
#pragma unroll 1
    for (int g = 0; g < NGRP; g++) {
      bf16_t* hb = p.h + (size_t)g * TG * D;
      const float lam_init = layer == 0 ? li0 : layer == 1 ? li1 : layer == 2 ? li2 : li3;
#pragma unroll 1
      for (int rep = 0; rep < repG; rep++)
      XCD_LOOP_SPREAD(MT * 36, it) inproj_item(p, hb, layer, it, smem);
      xcd_barrier(xb);
#pragma unroll 1
      for (int rep = 1; rep < repD; rep++) xcd_barrier(xb);
      {
        constexpr int N2 = MT * 6, N3 = MT * 8, N4 = MT;
        unsigned* ctr = p.qctr + 64 + (g * DEPTH + layer);
        int* sNext = (int*)(smem + SMEM_BYTES - 16);
        for (;;) {
          __syncthreads();
          if (tidx() == 0) *sNext = (int)atomicAdd(ctr, 1u);
          __syncthreads();
          const int it = *sNext;
          if (it >= N2 + N3 + N4) break;
          if (it < N4) kpe_item(p, it);
          else if (it < N4 + N2) upq_item(p, it - N4, smem);
          else upkv_item(p, it - N4 - N2, smem);
        }
      }
      xcd_barrier(xb);
      {
        static_assert(GB * 4 == 8 && GB * 8 == 16, "attention queue assumes 8 diff heads / 16 MLA heads per group");
        const int xhome = (int)(xb.x & 7u);
        int* sNext = (int*)(smem + SMEM_BYTES - 16);
        constexpr int QA = 32, QB_ = QA + 2 * NRNG, QC = QB_ + 34, QD = QC + 128, QE = QD + NRNG, QF = QE + 132;
#pragma unroll 1
        for (int qd = 0; qd < 8; qd++) {
          const int xq = (xhome + qd) & 7;
          unsigned* dep = p.dep + (g * DEPTH + layer) * 512 + xq * 8;
          unsigned* ctr = p.qctr + (g * DEPTH + layer) * 8 + xq;
          bool rdy1a = false, rdy1b = false, rdy2 = false;
          for (;;) {
            __syncthreads();
            if (tidx() == 0) *sNext = (int)atomicAdd(ctr, 1u);
            __syncthreads();
            const int it = *sNext;
            if (it >= QF) break;
            if (it < QA) {
              diff_item(p, layer, lam_init, xq, (it + 2) % 66, smem);
            } else if (it < QB_) {
              const int j = it - QA, dir = j / NRNG, rng = j % NRNG;
              hg1_item(p, layer, xq * 2 + dir, rng, smem);
              dep_publish(dep + dir, nullptr);
            } else if (it < QC) {
              diff_item(p, layer, lam_init, xq, (it - QB_ + QA + 2) % 66, smem);
            } else if (it < QD) {
              const int j = it - QC, dir = j >> 6, sl = j & 63;
              if (!(dir ? rdy1b : rdy1a)) {
                dep_wait(dep + dir, (unsigned)NRNG, p.xbar);
                if (dir) rdy1b = true; else rdy1a = true;
              }
              hg2_item(p, xq * 2 + dir, sl);
              dep_publish(dep + 2, nullptr);
            } else if (it < QE) {
              if (!rdy2) {
                dep_wait(dep + 2, 128u, p.xbar);
                rdy2 = true;
              }
              hg3_item(p, layer, xq, it - QD, smem);
            } else {
              const int j = it - QE;
              mla_item(p, 2 * xq + j / 66, (j % 66 + 2) % 66, smem);
            }
          }
        }
      }
      xcd_barrier(xb);
#pragma unroll 1
      for (int rep = 0; rep < repG; rep++)
      XCD_LOOP(MERGE_FULL, it) merge_item(p, hb, layer, it, smem);
      for (int it = MERGE_FULL + bid; it < MERGE_ITEMS; it += nblk) merge_item(p, hb, layer, it, smem);
      xcd_barrier(xb);
      XCD_LOOP(RES_FULL, it) resid_item(p, g, layer, it, p.mbuf, D, p.wo_t, 2 * D, smem);
      for (int it = RES_FULL + bid; it < RES_ITEMS; it += nblk) resid_item(p, g, layer, it, p.mbuf, D, p.wo_t, 2 * D, smem);
      xcd_barrier(xb);
      rowpass_rows(p, hb, g, rp0, rp1, 1, 1, p.ln1_g + layer * D, p.ln1_b + layer * D, layer, 3 * D, true);
      xcd_barrier(xb);
#pragma unroll 1
      for (int rep = 0; rep < repG; rep++)
      XCD_LOOP_SPREAD(MT * 22, it) ffn1_item(p, hb, it, smem);
      xcd_barrier(xb);
      XCD_LOOP(RES_FULL, it) resid_item(p, g, layer, it, p.hid, FFH, p.wff2_t, 5 * D, smem);
      for (int it = RES_FULL + bid; it < RES_ITEMS; it += nblk) resid_item(p, g, layer, it, p.hid, FFH, p.wff2_t, 5 * D, smem);
      xcd_barrier(xb);
      {
        const bool last_layer = layer == DEPTH - 1;
        rowpass_rows(p, hb, g, rp0, rp1, 1, 1, p.ln2_g + layer * D, p.ln2_b + layer * D, layer + 1, 0, !last_layer);
        if (g == NGRP - 1 && !last_layer)
          for (int it = bid; it < CV_TOTAL; it += nblk) conv_item(p, layer + 1, it, smem);
      }
      xcd_barrier(xb);
    }
  }
}

static inline size_t align_up(size_t v) { return (v + 255) & ~(size_t)255; }

extern "C" void kernel_launch(void* const* d_in, const int* in_sizes, int n_in, void* d_out, int out_size, void* d_ws,
                              size_t ws_size, hipStream_t stream) {
  static int grid_blocks = 0;
  if (!grid_blocks) {
    int dev = 0, cus = 0, per_cu = 0;
    hipGetDevice(&dev);
    hipDeviceGetAttribute(&cus, hipDeviceAttributeMultiprocessorCount, dev);
    hipOccupancyMaxActiveBlocksPerMultiprocessor(&per_cu, mega_kernel, 256, 0);
    if (per_cu > 2) per_cu = 2;
    if (per_cu < 1) per_cu = 1;
    grid_blocks = cus * per_cu;
  }
  Params p{};
  const float* const* in = (const float* const*)d_in;
  p.x = in[0]; p.c = in[1]; p.ctx = in[2]; p.c_ctx = in[3]; p.w_mod = in[4]; p.b_mod = in[5]; p.w_in = in[6];
  p.qn = in[7]; p.kvn = in[8]; p.w_uq = in[9]; p.w_ukv = in[10]; p.lb_logits = in[11]; p.hg_norm = in[12];
  p.diff_lambda = in[13]; p.diff_subln = in[14]; p.w_branch = in[15]; p.w_gate = in[16]; p.b_gate = in[17];
  p.w_o = in[18]; p.ln1_g = in[19]; p.ln1_b = in[20]; p.w_ff1 = in[21]; p.w_ff2 = in[22]; p.ln2_g = in[23]; p.ln2_b = in[24];
  p.out = (float*)d_out;
  char* ws = (char*)d_ws;
  size_t off = 0;
  auto take = [&](size_t bytes) { char* r = ws + off; off = align_up(off + bytes); return r; };
  p.mod = (float*)take((size_t)DEPTH * 5 * 6 * D * 4);
  p.ctxres = (float*)take((size_t)NBATCH * CTX * D * 4);
  p.win_t = (bf16_t*)take((size_t)INWP * D * 2);
  p.wuq_t = (bf16_t*)take((size_t)768 * 256 * 2);
  p.wukv_t = (bf16_t*)take((size_t)1024 * 128 * 2);
  p.wg_t = (bf16_t*)take((size_t)3 * D * D * 2);
  p.wb_t = (bf16_t*)take((size_t)3 * D * 512 * 2);
  p.wo_t = (bf16_t*)take((size_t)D * D * 2);
  p.wff1_t = (bf16_t*)take((size_t)2 * FFH * D * 2);
  p.wff2_t = (bf16_t*)take((size_t)D * FFH * 2);
  p.h = (bf16_t*)take((size_t)NGRP * TG * D * 2);
  p.cbuf = (bf16_t*)take((size_t)TG * 416 * 2);
  p.Qm = (bf16_t*)take((size_t)TG * 768 * 2);
  p.Km = (bf16_t*)take((size_t)TG * 768 * 2);
  p.mbuf = p.Qm;
  p.Vtm = (bf16_t*)take((size_t)TG * 512 * 2);
  p.hq = (bf16_t*)take((size_t)TG * 512 * 2);
  p.zf = (bf16_t*)take((size_t)TG * 512 * 2);
  p.zb = (bf16_t*)take((size_t)TG * 512 * 2);
  p.hi = (bf16_t*)take((size_t)TG * 512 * 2);
  p.hog = (bf16_t*)take((size_t)TG * 512 * 2);
  p.dq = (bf16_t*)take((size_t)TG * 512 * 2);
  p.hid = p.hq;
  p.dk = (bf16_t*)take((size_t)TG * 512 * 2);
  p.dvt = (bf16_t*)take((size_t)TG * 512 * 2);
  p.gf = (bf16_t*)take((size_t)TG * 512 * 2);
  p.gb = (bf16_t*)take((size_t)TG * 512 * 2);
  p.ymla = (bf16_t*)take((size_t)TG * 512 * 2);
  p.yhg = (bf16_t*)take((size_t)TG * 512 * 2);
  p.ydiff = (bf16_t*)take((size_t)TG * 512 * 2);
  p.hgst = (float*)take((size_t)GB * 4 * 2 * NRNG * 16384 * 4);
  p.hgdec = (float*)take((size_t)GB * 4 * 2 * NRNG * 128 * 4);
  p.osum = (float*)take((size_t)TG * 512 * 4);
  p.stash = (float*)take((size_t)grid_blocks * 64 * 256 * 4);
  p.qctr = (unsigned*)take(256 * 4);
  p.xbar = (unsigned*)take(XCD_BAR_WORDS * 4);
  p.dep = (unsigned*)take((size_t)NGRP * DEPTH * 512 * 4);
  if (off > ws_size) {
    fprintf(stderr, "workspace too small: need %zu have %zu\n", off, ws_size);
    return;
  }
  float li0 = 0.8f - 0.6f * expf(-0.3f * 0.f), li1 = 0.8f - 0.6f * expf(-0.3f * 1.f), li2 = 0.8f - 0.6f * expf(-0.3f * 2.f),
        li3 = 0.8f - 0.6f * expf(-0.3f * 3.f);
  int repD = REP_D, repG = REP_G, repH = REP_H;
  void* args[] = {&p, &li0, &li1, &li2, &li3, &repD, &repG, &repH};
  hipError_t e = hipLaunchCooperativeKernel((void*)mega_kernel, dim3(grid_blocks), dim3(256), args, 0, stream);
  if (e != hipSuccess) fprintf(stderr, "cooperative launch failed: %s (grid %d)\n", hipGetErrorString(e), grid_blocks);
}
```

```cpp
#include <hip/hip_runtime.h>
#include <hip/hip_cooperative_groups.h>
#include <cstdio>
namespace cg = cooperative_groups;

#define DI __device__ __forceinline__
typedef unsigned short bf16_t;
typedef __attribute__((ext_vector_type(8))) short bf16x8;
typedef __attribute__((ext_vector_type(4))) short bf16x4;
typedef __attribute__((ext_vector_type(16))) float f32x16;
typedef unsigned u32x4 __attribute__((ext_vector_type(4)));
typedef unsigned u32x2 __attribute__((ext_vector_type(2)));
typedef __bf16 bfv2 __attribute__((ext_vector_type(2)));
typedef float fv2 __attribute__((ext_vector_type(2)));
#define MFMA(a, b, c) __builtin_amdgcn_mfma_f32_32x32x16_bf16((a), (b), (c), 0, 0, 0)

constexpr int D = 1024;
constexpr int NBATCH = 4;
constexpr int SEQ = 8192;
constexpr int CTX = 256;
constexpr int LP = SEQ + CTX;
constexpr int GB = 2;
constexpr int NGRP = NBATCH / GB;
constexpr int TG = GB * LP;
constexpr int MT = TG / 128;
constexpr int DEPTH = 4;
constexpr int INW = 4512;
constexpr int INWP = 4608;
constexpr int FFH = 2816;
constexpr int NRNG = 33;
constexpr float LOG2E = 1.4426950408889634f;
constexpr float MLA_QSCALE = 0.10206207261596577f * LOG2E;
constexpr float DIFF_QSCALE = 0.125f * LOG2E;
constexpr float HG_SCALE = 0.08838834764831845f;
constexpr float ALPHA = 1.681792830507429f;
constexpr float LOG2_10000 = 13.287712379549449f;
constexpr int SMEM_BYTES = 54 * 1024 + 64;
#ifndef REP_D
#define REP_D 1
#endif
#ifndef REP_G
#define REP_G 1
#endif
#ifndef REP_H
#define REP_H 1
#endif

struct Params {
  const float *x, *c, *ctx, *c_ctx, *w_mod, *b_mod, *w_in, *qn, *kvn, *w_uq, *w_ukv, *lb_logits, *hg_norm,
      *diff_lambda, *diff_subln, *w_branch, *w_gate, *b_gate, *w_o, *ln1_g, *ln1_b, *w_ff1, *w_ff2, *ln2_g, *ln2_b;
  float* out;
  float *mod, *ctxres;
  bf16_t *win_t, *wuq_t, *wukv_t, *wg_t, *wb_t, *wo_t, *wff1_t, *wff2_t;
  bf16_t *h, *cbuf, *Qm, *Km, *Vtm, *hq, *zf, *zb, *gf, *gb, *hi, *hog, *dq, *dk, *dvt, *ymla, *yhg, *ydiff, *mbuf, *hid;
  float *hgst, *hgdec, *osum, *stash;
  unsigned* qctr;
  unsigned* xbar;
  unsigned* dep;
};

DI int tidx() {
  int t = threadIdx.x;
  asm volatile("" : "+v"(t));
  return t;
}
DI float bf2f(bf16_t v) { return __uint_as_float(((unsigned)v) << 16); }
DI unsigned pk2(float a, float b) {
  fv2 v = {a, b};
  bfv2 r = __builtin_convertvector(v, bfv2);
  return __builtin_bit_cast(unsigned, r);
}
DI bf16_t f2bf(float a) { return (bf16_t)(pk2(a, 0.f) & 0xffffu); }
DI int crow(int i, int hh) { return (i & 3) + 8 * (i >> 2) + 4 * hh; }
DI float silu_f(float x) { return x / (1.f + __expf(-x)); }
DI float sigmoid_f(float x) { return 1.f / (1.f + __expf(-x)); }
DI bf16x8 pack8(const f32x16& x, const int s) {
  u32x4 u;
  u.x = pk2(x[8 * s + 0], x[8 * s + 1]);
  u.y = pk2(x[8 * s + 2], x[8 * s + 3]);
  u.z = pk2(x[8 * s + 4], x[8 * s + 5]);
  u.w = pk2(x[8 * s + 6], x[8 * s + 7]);
  return __builtin_bit_cast(bf16x8, u);
}
DI float xor32_max(float v) {
  auto r = __builtin_amdgcn_permlane32_swap(__float_as_uint(v), __float_as_uint(v), false, false);
  return fmaxf(__uint_as_float(r[0]), __uint_as_float(r[1]));
}
DI bf16x8 cat4(bf16x4 lo, bf16x4 hi) { return __builtin_shufflevector(lo, hi, 0, 1, 2, 3, 4, 5, 6, 7); }
DI void zero16(f32x16& a) {
#pragma unroll
  for (int i = 0; i < 16; i++) a[i] = 0.f;
}

DI void patch_decode(int L, int mtiles, int ntiles, int& m, int& n) {
  const int per = 8 * ntiles;
  const int sr = L / per, q = L - sr * per;
  const int mc = min(8, mtiles - sr * 8);
  n = q / mc;
  m = sr * 8 + (q - n * mc);
}

DI const float* xsrc_row(const Params& p, int g, int layer, int row) {
  const int bl = row / LP, pp = row - bl * LP, b = g * GB + bl;
  if (pp < CTX) return (layer == 0 ? p.ctx : p.ctxres) + ((size_t)(b * CTX + pp)) * D;
  return (layer == 0 ? p.x : p.out) + ((size_t)b * SEQ + (pp - CTX)) * D;
}
DI float* xdst_row(const Params& p, int g, int row) {
  const int bl = row / LP, pp = row - bl * LP, b = g * GB + bl;
  if (pp < CTX) return p.ctxres + ((size_t)(b * CTX + pp)) * D;
  return p.out + ((size_t)b * SEQ + (pp - CTX)) * D;
}
DI const float* mod_row(const Params& p, int g, int layer, int row) {
  const int bl = row / LP, pp = row - bl * LP, b = g * GB + bl;
  return p.mod + ((size_t)(layer * 5 + (pp < CTX ? 4 : b))) * (6 * D);
}

template <int TN>
DI void gemm_core(const bf16_t* __restrict__ A, int lda, const bf16_t* __restrict__ Bt, int ldb, int K,
                  f32x16 (&acc)[2][TN], bf16_t* sA, bf16_t* sB) {
  const int tid = tidx(), lane = tid & 63, w = tid >> 6;
  const int wm = w >> 1, wn = w & 1, r = lane & 31, hh = lane >> 5;
  const int lrow = tid >> 3, lk = (tid & 7) * 8;
  constexpr int NB = 2 * TN;
  u32x4 ra0[4], rb0[NB], ra1[4], rb1[NB];
  const bf16_t* Ap = A + (size_t)lrow * lda + lk;
  const bf16_t* Bp = Bt + (size_t)lrow * ldb + lk;
  const int nk = K >> 6;
#pragma unroll
  for (int i = 0; i < 4; i++) ra0[i] = *(const u32x4*)(Ap + (size_t)(32 * i) * lda);
#pragma unroll
  for (int i = 0; i < NB; i++) rb0[i] = *(const u32x4*)(Bp + (size_t)(32 * i) * ldb);
#pragma unroll
  for (int i = 0; i < 4; i++) ra1[i] = *(const u32x4*)(Ap + 64 + (size_t)(32 * i) * lda);
#pragma unroll
  for (int i = 0; i < NB; i++) rb1[i] = *(const u32x4*)(Bp + 64 + (size_t)(32 * i) * ldb);
  auto compute = [&]() {
#pragma unroll
    for (int ks = 0; ks < 4; ks++) {
      bf16x8 af[2], bfr[TN];
#pragma unroll
      for (int mt = 0; mt < 2; mt++) af[mt] = *(const bf16x8*)(sA + (wm * 64 + mt * 32 + r) * 72 + ks * 16 + hh * 8);
#pragma unroll
      for (int nt = 0; nt < TN; nt++) bfr[nt] = *(const bf16x8*)(sB + (wn * 32 * TN + nt * 32 + r) * 72 + ks * 16 + hh * 8);
#pragma unroll
      for (int mt = 0; mt < 2; mt++)
#pragma unroll
        for (int nt = 0; nt < TN; nt++) acc[mt][nt] = MFMA(af[mt], bfr[nt], acc[mt][nt]);
    }
  };
  for (int kt = 0; kt < nk; kt += 2) {
    __syncthreads();
#pragma unroll
    for (int i = 0; i < 4; i++) *(u32x4*)(sA + (lrow + 32 * i) * 72 + lk) = ra0[i];
#pragma unroll
    for (int i = 0; i < NB; i++) *(u32x4*)(sB + (lrow + 32 * i) * 72 + lk) = rb0[i];
    __syncthreads();
    if (kt + 2 < nk) {
#pragma unroll
      for (int i = 0; i < 4; i++) ra0[i] = *(const u32x4*)(Ap + (kt + 2) * 64 + (size_t)(32 * i) * lda);
#pragma unroll
      for (int i = 0; i < NB; i++) rb0[i] = *(const u32x4*)(Bp + (kt + 2) * 64 + (size_t)(32 * i) * ldb);
    }
    __builtin_amdgcn_sched_barrier(0);
    compute();
    __syncthreads();
#pragma unroll
    for (int i = 0; i < 4; i++) *(u32x4*)(sA + (lrow + 32 * i) * 72 + lk) = ra1[i];
#pragma unroll
    for (int i = 0; i < NB; i++) *(u32x4*)(sB + (lrow + 32 * i) * 72 + lk) = rb1[i];
    __syncthreads();
    if (kt + 3 < nk) {
#pragma unroll
      for (int i = 0; i < 4; i++) ra1[i] = *(const u32x4*)(Ap + (kt + 3) * 64 + (size_t)(32 * i) * lda);
#pragma unroll
      for (int i = 0; i < NB; i++) rb1[i] = *(const u32x4*)(Bp + (kt + 3) * 64 + (size_t)(32 * i) * ldb);
    }
    __builtin_amdgcn_sched_barrier(0);
    compute();
  }
}

DI void gemm_core1(const bf16_t* __restrict__ A, int lda, const bf16_t* __restrict__ Bt, int ldb, int K,
                   f32x16 (&acc)[2][2], bf16_t* sA, bf16_t* sB) {
  const int tid = tidx(), lane = tid & 63, w = tid >> 6;
  const int wm = w >> 1, wn = w & 1, r = lane & 31, hh = lane >> 5;
  const int lrow = tid >> 3, lk = (tid & 7) * 8;
  u32x4 ra[4], rb[4];
  const bf16_t* Ap = A + (size_t)lrow * lda + lk;
  const bf16_t* Bp = Bt + (size_t)lrow * ldb + lk;
#pragma unroll
  for (int i = 0; i < 4; i++) ra[i] = *(const u32x4*)(Ap + (size_t)(32 * i) * lda);
#pragma unroll
  for (int i = 0; i < 4; i++) rb[i] = *(const u32x4*)(Bp + (size_t)(32 * i) * ldb);
  const int nk = K >> 6;
  for (int kt = 0; kt < nk; kt++) {
    __syncthreads();
#pragma unroll
    for (int i = 0; i < 4; i++) *(u32x4*)(sA + (lrow + 32 * i) * 72 + lk) = ra[i];
#pragma unroll
    for (int i = 0; i < 4; i++) *(u32x4*)(sB + (lrow + 32 * i) * 72 + lk) = rb[i];
    __syncthreads();
    if (kt + 1 < nk) {
      Ap += 64;
      Bp += 64;
#pragma unroll
      for (int i = 0; i < 4; i++) ra[i] = *(const u32x4*)(Ap + (size_t)(32 * i) * lda);
#pragma unroll
      for (int i = 0; i < 4; i++) rb[i] = *(const u32x4*)(Bp + (size_t)(32 * i) * ldb);
    }
    __builtin_amdgcn_sched_barrier(0);
#pragma unroll
    for (int ks = 0; ks < 4; ks++) {
      bf16x8 af[2], bfr[2];
#pragma unroll
      for (int mt = 0; mt < 2; mt++) af[mt] = *(const bf16x8*)(sA + (wm * 64 + mt * 32 + r) * 72 + ks * 16 + hh * 8);
#pragma unroll
      for (int nt = 0; nt < 2; nt++) bfr[nt] = *(const bf16x8*)(sB + (wn * 64 + nt * 32 + r) * 72 + ks * 16 + hh * 8);
#pragma unroll
      for (int mt = 0; mt < 2; mt++)
#pragma unroll
        for (int nt = 0; nt < 2; nt++) acc[mt][nt] = MFMA(af[mt], bfr[nt], acc[mt][nt]);
    }
  }
}

DI void gemm_core_wide(const bf16_t* __restrict__ A, int lda, const bf16_t* __restrict__ Bt, int ldb, int K,
                       f32x16 (&acc)[2][4], bf16_t* sA, bf16_t* sB) {
  const int tid = tidx(), lane = tid & 63, w = tid >> 6;
  const int wm = w >> 1, wn = w & 1, r = lane & 31, hh = lane >> 5;
  const int lrow = tid >> 3, lk = (tid & 7) * 8;
  u32x4 ra[4], rb[8];
  const bf16_t* Ap = A + (size_t)lrow * lda + lk;
  const bf16_t* Bp = Bt + (size_t)lrow * ldb + lk;
#pragma unroll
  for (int i = 0; i < 4; i++) ra[i] = *(const u32x4*)(Ap + (size_t)(32 * i) * lda);
#pragma unroll
  for (int i = 0; i < 8; i++) rb[i] = *(const u32x4*)(Bp + (size_t)(32 * i) * ldb);
  const int nk = K >> 6;
  for (int kt = 0; kt < nk; kt++) {
    __syncthreads();
#pragma unroll
    for (int i = 0; i < 4; i++) *(u32x4*)(sA + (lrow + 32 * i) * 72 + lk) = ra[i];
#pragma unroll
    for (int i = 0; i < 8; i++) *(u32x4*)(sB + (lrow + 32 * i) * 72 + lk) = rb[i];
    __syncthreads();
    if (kt + 1 < nk) {
      Ap += 64;
      Bp += 64;
#pragma unroll
      for (int i = 0; i < 4; i++) ra[i] = *(const u32x4*)(Ap + (size_t)(32 * i) * lda);
#pragma unroll
      for (int i = 0; i < 8; i++) rb[i] = *(const u32x4*)(Bp + (size_t)(32 * i) * ldb);
    }
    __builtin_amdgcn_sched_barrier(0);
#pragma unroll
    for (int ks = 0; ks < 4; ks++) {
      bf16x8 af[2], bfr[4];
#pragma unroll
      for (int mt = 0; mt < 2; mt++) af[mt] = *(const bf16x8*)(sA + (wm * 64 + mt * 32 + r) * 72 + ks * 16 + hh * 8);
#pragma unroll
      for (int nt = 0; nt < 4; nt++) bfr[nt] = *(const bf16x8*)(sB + (wn * 128 + nt * 32 + r) * 72 + ks * 16 + hh * 8);
#pragma unroll
      for (int mt = 0; mt < 2; mt++)
#pragma unroll
        for (int nt = 0; nt < 4; nt++) acc[mt][nt] = MFMA(af[mt], bfr[nt], acc[mt][nt]);
    }
  }
}

DI int map_col(int maptype, int n) {
  if (maptype == 1) return n < 416 ? 4096 + n : n - 416;
  if (maptype == 2) {
    const int up = n >= FFH ? 1 : 0;
    const int j = n - up * FFH;
    return (j >> 7) * 256 + ((j >> 6) & 1) * 128 + ((j >> 5) & 1) * 64 + up * 32 + (j & 31);
  }
  return n;
}
DI void conv_tile(const float* __restrict__ src, int K, int N, int k0, int n0, bf16_t* __restrict__ dst, int maptype,
                  const float* __restrict__ rowscale, float* sT) {
  const int tid = tidx();
  __syncthreads();
#pragma unroll
  for (int i = 0; i < 4; i++) {
    const int kk = (tid >> 4) + 16 * i, nl = (tid & 15) * 4, n = n0 + nl;
    float4 v = make_float4(0.f, 0.f, 0.f, 0.f);
    if (n < N) v = *(const float4*)(src + (size_t)(k0 + kk) * N + n);
    const float sc = rowscale ? rowscale[k0 + kk] : 1.f;
    sT[kk * 65 + nl + 0] = v.x * sc;
    sT[kk * 65 + nl + 1] = v.y * sc;
    sT[kk * 65 + nl + 2] = v.z * sc;
    sT[kk * 65 + nl + 3] = v.w * sc;
  }
  __syncthreads();
#pragma unroll
  for (int i = 0; i < 2; i++) {
    const int nl = (tid >> 3) + 32 * i, k8 = (tid & 7) * 8, n = n0 + nl;
    if (n < N) {
      u32x4 u;
      u.x = pk2(sT[(k8 + 0) * 65 + nl], sT[(k8 + 1) * 65 + nl]);
      u.y = pk2(sT[(k8 + 2) * 65 + nl], sT[(k8 + 3) * 65 + nl]);
      u.z = pk2(sT[(k8 + 4) * 65 + nl], sT[(k8 + 5) * 65 + nl]);
      u.w = pk2(sT[(k8 + 6) * 65 + nl], sT[(k8 + 7) * 65 + nl]);
      *(u32x4*)(dst + (size_t)map_col(maptype, n) * K + k0 + k8) = u;
    }
  }
}
constexpr int CV_IN = 16 * 71, CV_G = 3 * 256, CV_B = 3 * 8 * 16, CV_O = 256, CV_F1 = 16 * 88, CV_F2 = 44 * 16,
              CV_UQ = 4 * 12, CV_UKV = 2 * 16;
constexpr int CV_TOTAL = CV_IN + CV_G + CV_B + CV_O + CV_F1 + CV_F2 + CV_UQ + CV_UKV + 1;
DI void conv_item(const Params& p, int layer, int it, char* smem) {
  float* sT = (float*)smem;
  if (it < CV_IN) {
    conv_tile(p.w_in + (size_t)layer * D * INW, D, INW, (it / 71) * 64, (it % 71) * 64, p.win_t, 1, nullptr, sT);
    return;
  }
  it -= CV_IN;
  if (it < CV_G) {
    const int i = it >> 8, t = it & 255;
    conv_tile(p.w_gate + ((size_t)layer * 3 + i) * D * D, D, D, (t >> 4) * 64, (t & 15) * 64, p.wg_t + (size_t)i * D * D, 0, nullptr, sT);
    return;
  }
  it -= CV_G;
  if (it < CV_B) {
    const int i = it >> 7, t = it & 127;
    conv_tile(p.w_branch + ((size_t)layer * 3 + i) * 512 * D, 512, D, (t >> 4) * 64, (t & 15) * 64, p.wb_t + (size_t)i * D * 512, 0, nullptr, sT);
    return;
  }
  it -= CV_B;
  if (it < CV_O) {
    conv_tile(p.w_o + (size_t)layer * D * D, D, D, (it >> 4) * 64, (it & 15) * 64, p.wo_t, 0, nullptr, sT);
    return;
  }
  it -= CV_O;
  if (it < CV_F1) {
    conv_tile(p.w_ff1 + (size_t)layer * D * 2 * FFH, D, 2 * FFH, (it / 88) * 64, (it % 88) * 64, p.wff1_t, 2, nullptr, sT);
    return;
  }
  it -= CV_F1;
  if (it < CV_F2) {
    conv_tile(p.w_ff2 + (size_t)layer * FFH * D, FFH, D, (it >> 4) * 64, (it & 15) * 64, p.wff2_t, 0, nullptr, sT);
    return;
  }
  it -= CV_F2;
  if (it < CV_UQ) {
    conv_tile(p.w_uq + (size_t)layer * 256 * 768, 256, 768, (it / 12) * 64, (it % 12) * 64, p.wuq_t, 0, p.qn + layer * 256, sT);
    return;
  }
  it -= CV_UQ;
  if (it < CV_UKV) {
    conv_tile(p.w_ukv + (size_t)layer * 128 * 1024, 128, 1024, (it >> 4) * 64, (it & 15) * 64, p.wukv_t, 0, p.kvn + layer * 128, sT);
    return;
  }
  u32x4 z = u32x4{0u, 0u, 0u, 0u};
  for (int e = tidx(); e < 96 * D / 8; e += 256) *(u32x4*)(p.win_t + (size_t)INW * D + (size_t)e * 8) = z;
}

DI void mod_item(const Params& p, int it, char* smem) {
  float* sC = (float*)smem;
  float* sR = sC + 5 * D;
  const int layer = it / 96, cb = it % 96;
  __syncthreads();
  for (int e = tidx(); e < 5 * D; e += 256) {
    const float v = e < 4 * D ? p.c[e] : p.c_ctx[e - 4 * D];
    sC[e] = silu_f(v);
  }
  __syncthreads();
  const int tid = tidx(), cl = tid & 63, kp = tid >> 6;
  const int n = cb * 64 + cl;
  const float* W = p.w_mod + (size_t)layer * D * 6 * D + (size_t)(kp * 256) * 6 * D + n;
  const float* cc = sC + kp * 256;
  float a0 = 0.f, a1 = 0.f, a2 = 0.f, a3 = 0.f, a4 = 0.f;
#pragma unroll 8
  for (int k = 0; k < 256; k++) {
    const float wv = W[(size_t)k * 6 * D];
    a0 += cc[k] * wv;
    a1 += cc[D + k] * wv;
    a2 += cc[2 * D + k] * wv;
    a3 += cc[3 * D + k] * wv;
    a4 += cc[4 * D + k] * wv;
  }
  sR[(kp * 5 + 0) * 64 + cl] = a0;
  sR[(kp * 5 + 1) * 64 + cl] = a1;
  sR[(kp * 5 + 2) * 64 + cl] = a2;
  sR[(kp * 5 + 3) * 64 + cl] = a3;
  sR[(kp * 5 + 4) * 64 + cl] = a4;
  __syncthreads();
  if (tid < 64) {
    const float bb = p.b_mod[layer * 6 * D + n];
    float* o = p.mod + (size_t)layer * 5 * 6 * D + n;
#pragma unroll
    for (int r = 0; r < 5; r++)
      o[(size_t)r * 6 * D] = sR[(0 * 5 + r) * 64 + tid] + sR[(1 * 5 + r) * 64 + tid] + sR[(2 * 5 + r) * 64 + tid] + sR[(3 * 5 + r) * 64 + tid] + bb;
  }
}

DI void rowpass_rows(const Params& p, bf16_t* hb, int g, int r0, int r1, int mode, int src_layer, const float* lng, const float* lnb,
                     int mod_layer, int mod_off, bool need_h) {
  const int lane = tidx() & 63, w = tidx() >> 6;
  float4 v[4], nv[4];
  if (r0 + w < r1) {
    const float* src0 = xsrc_row(p, g, src_layer, r0 + w);
#pragma unroll
    for (int j = 0; j < 4; j++) nv[j] = *(const float4*)(src0 + lane * 4 + 256 * j);
  }
#pragma unroll 1
  for (int row = r0 + w; row < r1; row += 4) {
#pragma unroll
    for (int j = 0; j < 4; j++) v[j] = nv[j];
    if (row + 4 < r1) {
      const float* srcn = xsrc_row(p, g, src_layer, row + 4);
#pragma unroll
      for (int j = 0; j < 4; j++) nv[j] = *(const float4*)(srcn + lane * 4 + 256 * j);
    }
    if (mode == 1) {
      float s = 0.f;
#pragma unroll
      for (int j = 0; j < 4; j++) s += v[j].x + v[j].y + v[j].z + v[j].w;
#pragma unroll
      for (int o = 32; o >= 1; o >>= 1) s += __shfl_xor(s, o);
      const float mu = s * (1.f / D);
      float q = 0.f;
#pragma unroll
      for (int j = 0; j < 4; j++) {
        v[j].x -= mu; v[j].y -= mu; v[j].z -= mu; v[j].w -= mu;
        q += v[j].x * v[j].x + v[j].y * v[j].y + v[j].z * v[j].z + v[j].w * v[j].w;
      }
#pragma unroll
      for (int o = 32; o >= 1; o >>= 1) q += __shfl_xor(q, o);
      const float rstd = rsqrtf(q * (1.f / D) + 1e-5f);
      float* dst = xdst_row(p, g, row);
#pragma unroll
      for (int j = 0; j < 4; j++) {
        const float4 gg = *(const float4*)(lng + lane * 4 + 256 * j);
        const float4 bb = *(const float4*)(lnb + lane * 4 + 256 * j);
        v[j].x = v[j].x * rstd * gg.x + bb.x;
        v[j].y = v[j].y * rstd * gg.y + bb.y;
        v[j].z = v[j].z * rstd * gg.z + bb.z;
        v[j].w = v[j].w * rstd * gg.w + bb.w;
        *(float4*)(dst + lane * 4 + 256 * j) = v[j];
      }
    }
    if (need_h) {
      const float* md = mod_row(p, g, mod_layer, row) + mod_off;
#pragma unroll
      for (int j = 0; j < 4; j++) {
        const float4 sh = *(const float4*)(md + lane * 4 + 256 * j);
        const float4 sc = *(const float4*)(md + D + lane * 4 + 256 * j);
        u32x2 u;
        u.x = pk2(v[j].x * (1.f + sc.x) + sh.x, v[j].y * (1.f + sc.y) + sh.y);
        u.y = pk2(v[j].z * (1.f + sc.z) + sh.z, v[j].w * (1.f + sc.w) + sh.w);
        *(u32x2*)(hb + (size_t)row * D + lane * 4 + 256 * j) = u;
      }
    }
  }
}

DI float hg_lower_bound(const Params& p, int dir, int layer, int col);
DI void inproj_item(const Params& p, const bf16_t* hb, int layer, int it, char* smem) {
  bf16_t* sA = (bf16_t*)smem;
  bf16_t* sB = sA + 128 * 72;
  int mti, nti;
  patch_decode(it, MT, 36, mti, nti);
  const int m0 = mti * 128, n0 = nti * 128;
  f32x16 acc[2][2];
#pragma unroll
  for (int a = 0; a < 2; a++)
#pragma unroll
    for (int b = 0; b < 2; b++) zero16(acc[a][b]);
  gemm_core<2>(hb + (size_t)m0 * D, D, p.win_t + (size_t)n0 * D, D, D, acc, sA, sB);
  const int lane = tidx() & 63, w = tidx() >> 6, wm = w >> 1, wn = w & 1, r = lane & 31, hh = lane >> 5;
  const int bl = m0 / LP, pb = m0 - bl * LP;
  const bool isctx = pb < CTX;
  const int seg = n0 >> 9;
  const int cw = n0 + wn * 64;
  const int rowb = m0 + wm * 64;
  if (seg == 1 || seg == 2) {
    bf16_t* dk_ = seg == 1 ? p.zf : p.zb;
    bf16_t* dg_ = seg == 1 ? p.gf : p.gb;
    const int cc = cw - seg * 512;
#pragma unroll
    for (int nt = 0; nt < 2; nt++) {
      const int col = cc + nt * 32 + r;
      const float lb = hg_lower_bound(p, seg - 1, layer, col);
#pragma unroll
      for (int mt = 0; mt < 2; mt++)
#pragma unroll
        for (int i = 0; i < 16; i++) {
          const int row = rowb + mt * 32 + crow(i, hh);
          const float z = acc[mt][nt][i];
          const float ez = __expf(-fabsf(z));
          const float ls = fminf(z, 0.f) - __logf(1.f + ez);
          const float lf = lb > 0.f ? __logf(lb + (1.f - lb) * __expf(ls)) : ls;
          const float kv = (1.f - lb) * __expf(ls - z);
          dk_[(size_t)row * 512 + col] = f2bf(kv);
          dg_[(size_t)row * 512 + col] = f2bf(lf);
        }
    }
  } else if (seg <= 4) {
    bf16_t* dst = seg == 0 ? p.hq : seg == 3 ? p.hi : p.hog;
    const int cc = cw - seg * 512;
#pragma unroll
    for (int mt = 0; mt < 2; mt++)
#pragma unroll
      for (int nt = 0; nt < 2; nt++)
#pragma unroll
        for (int i = 0; i < 16; i++) {
          const int row = rowb + mt * 32 + crow(i, hh);
          float v = acc[mt][nt][i];
          if (seg == 0) v = silu_f(v) * HG_SCALE;
          dst[(size_t)row * 512 + cc + nt * 32 + r] = f2bf(v);
        }
  } else if (seg <= 6) {
    const int cc = cw - seg * 512;
    const int hd = cc >> 7, half = (cc >> 6) & 1;
    bf16_t* dst = (seg == 5 ? p.dq : p.dk) + ((size_t)((bl * 4 + hd) * 2 + half) * LP) * 64;
    const float sc = seg == 5 ? DIFF_QSCALE : 1.f;
    const float invf = exp2f(-(float)(r & 15) * (LOG2_10000 / 16.f));
#pragma unroll
    for (int mt = 0; mt < 2; mt++)
#pragma unroll
      for (int i = 0; i < 16; i++) {
        const int pp = rowb + mt * 32 + crow(i, hh) - bl * LP;
        float x1 = acc[mt][0][i], x2 = acc[mt][1][i];
        if (!isctx) {
          const int t = pp - CTX;
          const float pos = (float)(r < 16 ? (t >> 6) : (t & 63));
          const float ang = pos * invf;
          const float cs = __cosf(ang), sn = __sinf(ang);
          const float o1 = x1 * cs - x2 * sn, o2 = x1 * sn + x2 * cs;
          x1 = o1;
          x2 = o2;
        }
        dst[(size_t)pp * 64 + r] = f2bf(x1 * sc);
        dst[(size_t)pp * 64 + 32 + r] = f2bf(x2 * sc);
      }
  } else if (seg == 7) {
    const int cc = cw - 3584;
    const int hd = cc >> 7, dvb = cc & 127;
    bf16_t* dst = p.dvt + ((size_t)(bl * 4 + hd) * 128) * LP;
#pragma unroll
    for (int mt = 0; mt < 2; mt++)
#pragma unroll
      for (int nt = 0; nt < 2; nt++)
#pragma unroll
        for (int gq = 0; gq < 4; gq++) {
          const int pp0 = rowb + mt * 32 + 8 * gq + 4 * hh - bl * LP;
          u32x2 u;
          u.x = pk2(acc[mt][nt][4 * gq + 0], acc[mt][nt][4 * gq + 1]);
          u.y = pk2(acc[mt][nt][4 * gq + 2], acc[mt][nt][4 * gq + 3]);
          *(u32x2*)(dst + (size_t)(dvb + nt * 32 + r) * LP + pp0) = u;
        }
  } else {
    const int cc = cw - 4096;
#pragma unroll
    for (int mt = 0; mt < 2; mt++)
#pragma unroll
      for (int nt = 0; nt < 2; nt++) {
        const int col = cc + nt * 32 + r;
        if (col < 416) {
#pragma unroll
          for (int i = 0; i < 16; i++) {
            const int row = rowb + mt * 32 + crow(i, hh);
            p.cbuf[(size_t)row * 416 + col] = f2bf(acc[mt][nt][i]);
          }
        }
      }
  }
}

DI void upq_item(const Params& p, int it, char* smem) {
  bf16_t* sA = (bf16_t*)smem;
  bf16_t* sB = sA + 128 * 72;
  float* sRS = (float*)(smem + 2 * 128 * 72 * 2);
  int mti, nti;
  patch_decode(it, MT, 6, mti, nti);
  const int m0 = mti * 128, n0 = nti * 128;
  const int tid = tidx();
  __syncthreads();
  {
    const int row = tid >> 1, part = tid & 1;
    const bf16_t* src = p.cbuf + (size_t)(m0 + row) * 416 + part * 128;
    float ss = 0.f;
#pragma unroll
    for (int j = 0; j < 16; j++) {
      const u32x4 u = *(const u32x4*)(src + j * 8);
      const unsigned uu[4] = {u.x, u.y, u.z, u.w};
#pragma unroll
      for (int q = 0; q < 4; q++) {
        const float a = __uint_as_float(uu[q] << 16), b = __uint_as_float(uu[q] & 0xffff0000u);
        ss += a * a + b * b;
      }
    }
    ss += __shfl_xor(ss, 1);
    if (part == 0) sRS[row] = rsqrtf(ss * (1.f / 256.f) + 1e-6f);
  }
  f32x16 acc[2][2];
#pragma unroll
  for (int a = 0; a < 2; a++)
#pragma unroll
    for (int b = 0; b < 2; b++) zero16(acc[a][b]);
  gemm_core<2>(p.cbuf + (size_t)m0 * 416, 416, p.wuq_t + (size_t)n0 * 256, 256, 256, acc, sA, sB);
  const int lane = tid & 63, w = tid >> 6, wm = w >> 1, wn = w & 1, r = lane & 31, hh = lane >> 5;
  const int bl = m0 / LP, pb = m0 - bl * LP;
  const bool isctx = pb < CTX;
  const float invf = exp2f(-(float)(r & 7) * (LOG2_10000 / 8.f));
#pragma unroll
  for (int mt = 0; mt < 2; mt++)
#pragma unroll
    for (int nt = 0; nt < 2; nt++) {
      const int nb = n0 + wn * 64 + nt * 32;
      const int hd = nb / 96, d0 = nb - hd * 96;
      const bool ispe = (d0 == 64) && !isctx;
      bf16_t* dst = p.Qm + ((size_t)(bl * 8 + hd) * LP) * 96 + d0 + r;
#pragma unroll
      for (int i = 0; i < 16; i++) {
        const int rl = wm * 64 + mt * 32 + crow(i, hh);
        const int pp = pb + rl;
        float v = acc[mt][nt][i] * sRS[rl];
        if (ispe) {
          const float pv = __shfl_xor(v, 16);
          const int t = pp - CTX;
          const float pos = (float)((r & 15) < 8 ? (t >> 6) : (t & 63));
          const float ang = pos * invf;
          const float cs = __cosf(ang), sn = __sinf(ang);
          v = (r < 16) ? (v * cs - pv * sn) : (pv * sn + v * cs);
        }
        dst[(size_t)pp * 96] = f2bf(v * MLA_QSCALE);
      }
    }
}
DI void upkv_item(const Params& p, int it, char* smem) {
  bf16_t* sA = (bf16_t*)smem;
  bf16_t* sB = sA + 128 * 72;
  float* sRS = (float*)(smem + 2 * 128 * 72 * 2);
  int mti, hd;
  patch_decode(it, MT, 8, mti, hd);
  const int m0 = mti * 128, n0 = hd * 128;
  const int tid = tidx();
  __syncthreads();
  {
    const int row = tid >> 1, part = tid & 1;
    const bf16_t* src = p.cbuf + (size_t)(m0 + row) * 416 + 256 + part * 64;
    float ss = 0.f;
#pragma unroll
    for (int j = 0; j < 8; j++) {
      const u32x4 u = *(const u32x4*)(src + j * 8);
      const unsigned uu[4] = {u.x, u.y, u.z, u.w};
#pragma unroll
      for (int q = 0; q < 4; q++) {
        const float a = __uint_as_float(uu[q] << 16), b = __uint_as_float(uu[q] & 0xffff0000u);
        ss += a * a + b * b;
      }
    }
    ss += __shfl_xor(ss, 1);
    if (part == 0) sRS[row] = rsqrtf(ss * (1.f / 128.f) + 1e-6f);
  }
  f32x16 acc[2][2];
#pragma unroll
  for (int a = 0; a < 2; a++)
#pragma unroll
    for (int b = 0; b < 2; b++) zero16(acc[a][b]);
  gemm_core<2>(p.cbuf + (size_t)m0 * 416 + 256, 416, p.wukv_t + (size_t)n0 * 128, 128, 128, acc, sA, sB);
  const int lane = tid & 63, w = tid >> 6, wm = w >> 1, wn = w & 1, r = lane & 31, hh = lane >> 5;
  const int bl = m0 / LP, pb = m0 - bl * LP;
  if (wn == 0) {
    bf16_t* dst = p.Km + ((size_t)(bl * 8 + hd) * LP) * 96;
#pragma unroll
    for (int mt = 0; mt < 2; mt++)
#pragma unroll
      for (int nt = 0; nt < 2; nt++)
#pragma unroll
        for (int i = 0; i < 16; i++) {
          const int rl = wm * 64 + mt * 32 + crow(i, hh);
          dst[(size_t)(pb + rl) * 96 + nt * 32 + r] = f2bf(acc[mt][nt][i] * sRS[rl]);
        }
  } else {
    bf16_t* dst = p.Vtm + ((size_t)(bl * 8 + hd) * 64) * LP;
#pragma unroll
    for (int mt = 0; mt < 2; mt++)
#pragma unroll
      for (int nt = 0; nt < 2; nt++)
#pragma unroll
        for (int gq = 0; gq < 4; gq++) {
          const int rl = wm * 64 + mt * 32 + 8 * gq + 4 * hh;
          u32x2 u;
          u.x = pk2(acc[mt][nt][4 * gq + 0] * sRS[rl + 0], acc[mt][nt][4 * gq + 1] * sRS[rl + 1]);
          u.y = pk2(acc[mt][nt][4 * gq + 2] * sRS[rl + 2], acc[mt][nt][4 * gq + 3] * sRS[rl + 3]);
          *(u32x2*)(dst + (size_t)(nt * 32 + r) * LP + pb + rl) = u;
        }
  }
}
DI void kpe_item(const Params& p, int it) {
  const int m0 = it * 128;
  const int tid = tidx(), row = m0 + (tid >> 1), part = tid & 1;
  const int bl = m0 / LP, pp = row - bl * LP;
  const bool isctx = pp < CTX;
  const bf16_t* src = p.cbuf + (size_t)row * 416 + 384;
#pragma unroll
  for (int jj = 0; jj < 8; jj++) {
    const int j = part * 8 + jj;
    float x1 = bf2f(src[j]), x2 = bf2f(src[j + 16]);
    if (!isctx) {
      const int t = pp - CTX;
      const float invf = exp2f(-(float)(j & 7) * (LOG2_10000 / 8.f));
      const float pos = (float)(j < 8 ? (t >> 6) : (t & 63));
      const float ang = pos * invf;
      const float cs = __cosf(ang), sn = __sinf(ang);
      const float o1 = x1 * cs - x2 * sn, o2 = x1 * sn + x2 * cs;
      x1 = o1;
      x2 = o2;
    }
    const bf16_t b1 = f2bf(x1), b2 = f2bf(x2);
#pragma unroll
    for (int hd = 0; hd < 8; hd++) {
      bf16_t* dst = p.Km + ((size_t)(bl * 8 + hd) * LP + pp) * 96 + 64;
      dst[j] = b1;
      dst[j + 16] = b2;
    }
  }
}

template <int DQK, int DV>
DI void flash_core(const bf16_t* __restrict__ Q, const bf16_t* __restrict__ Kb, const bf16_t* __restrict__ Vt, int nkt,
                   f32x16 (&O)[DV / 32], float& lsum_out, char* smem) {
  constexpr int KS = DQK + 8;
  constexpr int VS = 72;
  constexpr int KCH = 64 * DQK / 8 / 256;
  constexpr int VCH = DV * 8 / 256;
  constexpr int BUF = 64 * KS + DV * VS;
  constexpr int CPR = DQK / 8;
  bf16_t* sbase = (bf16_t*)smem;
  const int tid = tidx(), lane = tid & 63, w = tid >> 6, r = lane & 31, hh = lane >> 5;
  bf16x8 qf[DQK / 16];
  {
    const bf16_t* qp = Q + (size_t)(w * 32 + r) * DQK + hh * 8;
#pragma unroll
    for (int ks = 0; ks < DQK / 16; ks++) qf[ks] = *(const bf16x8*)(qp + ks * 16);
  }
#pragma unroll
  for (int d = 0; d < DV / 32; d++) zero16(O[d]);
  float m_run = 0.f, l_run = 0.f;
  constexpr bool NEGM = (DV <= 64);
  f32x16 negm;
  zero16(negm);
  u32x4 rk[KCH], rv[VCH];
  auto gload = [&](int kt) {
#pragma unroll
    for (int i = 0; i < KCH; i++) rk[i] = *(const u32x4*)(Kb + (size_t)kt * 64 * DQK + (size_t)(tid + 256 * i) * 8);
#pragma unroll
    for (int i = 0; i < VCH; i++) {
      const int c = tid + 256 * i;
      rv[i] = *(const u32x4*)(Vt + (size_t)(c >> 3) * LP + kt * 64 + (c & 7) * 8);
    }
  };
  auto sstore = [&](int buf) {
    bf16_t* sK = sbase + buf * BUF;
    bf16_t* sV = sK + 64 * KS;
#pragma unroll
    for (int i = 0; i < KCH; i++) {
      const int c = tid + 256 * i;
      const int krow_ = c / CPR;
      const int prow_ = (krow_ & ~12) | ((krow_ & 4) << 1) | ((krow_ & 8) >> 1);
      *(u32x4*)(sK + prow_ * KS + (c % CPR) * 8) = rk[i];
    }
#pragma unroll
    for (int i = 0; i < VCH; i++) {
      const int c = tid + 256 * i;
      *(u32x4*)(sV + (c >> 3) * VS + (c & 7) * 8) = rv[i];
    }
  };
  __syncthreads();
  gload(0);
  sstore(0);
  __syncthreads();
  for (int kt = 0; kt < nkt; kt++) {
    const int buf = kt & 1;
    if (kt + 1 < nkt) gload(kt + 1);
    const bf16_t* sK = sbase + buf * BUF;
    const bf16_t* sV = sK + 64 * KS;
    constexpr int NKS = DQK / 16, ND = DV / 32;
    f32x16 S[2];
    {
      bf16x8 kf[2][NKS];
#pragma unroll
      for (int kb = 0; kb < 2; kb++)
#pragma unroll
        for (int ks = 0; ks < NKS; ks++) kf[kb][ks] = *(const bf16x8*)(sK + (kb * 32 + r) * KS + ks * 16 + hh * 8);
      if (NEGM) {
        S[0] = MFMA(kf[0][0], qf[0], negm);
        S[1] = MFMA(kf[1][0], qf[0], negm);
      } else {
        zero16(S[0]);
        zero16(S[1]);
        S[0] = MFMA(kf[0][0], qf[0], S[0]);
        S[1] = MFMA(kf[1][0], qf[0], S[1]);
      }
#pragma unroll
      for (int ks = 1; ks < NKS; ks++) {
        S[0] = MFMA(kf[0][ks], qf[ks], S[0]);
        S[1] = MFMA(kf[1][ks], qf[ks], S[1]);
      }
    }
    bf16x8 vfa[ND], vfb[ND];
#pragma unroll
    for (int d = 0; d < ND; d++) {
      vfa[d] = *(const bf16x8*)(sV + (d * 32 + r) * VS + 8 * hh);
    }
    float mx = S[0][0];
#pragma unroll
    for (int i = 1; i < 16; i++) mx = fmaxf(mx, S[0][i]);
#pragma unroll
    for (int i = 0; i < 16; i++) mx = fmaxf(mx, S[1][i]);
    mx = xor32_max(mx);
    if (NEGM) {
      if (kt == 0 || __builtin_amdgcn_ballot_w64(mx > 8.f) != 0) {
        const float delta = kt == 0 ? mx : fmaxf(mx, 0.f);
        const float alpha = __builtin_amdgcn_exp2f(-delta);
        m_run += delta;
        l_run *= alpha;
#pragma unroll
        for (int d = 0; d < ND; d++)
#pragma unroll
          for (int i = 0; i < 16; i++) O[d][i] *= alpha;
#pragma unroll
        for (int i = 0; i < 16; i++) {
          negm[i] = -m_run;
          S[0][i] -= delta;
          S[1][i] -= delta;
        }
      }
    } else {
      if (kt == 0 || __builtin_amdgcn_ballot_w64(mx > m_run + 8.f) != 0) {
        const float m_new = kt == 0 ? mx : fmaxf(m_run, mx);
        const float alpha = __builtin_amdgcn_exp2f(m_run - m_new);
        m_run = m_new;
        l_run *= alpha;
#pragma unroll
        for (int d = 0; d < ND; d++)
#pragma unroll
          for (int i = 0; i < 16; i++) O[d][i] *= alpha;
      }
    }
    float ls = 0.f;
#pragma unroll
    for (int kb = 0; kb < 2; kb++)
#pragma unroll
      for (int i = 0; i < 16; i++) {
        const float pv = __builtin_amdgcn_exp2f(NEGM ? S[kb][i] : S[kb][i] - m_run);
        S[kb][i] = pv;
        ls += pv;
      }
    l_run += ls;
    bf16x8 pf[2][2];
#pragma unroll
    for (int kb = 0; kb < 2; kb++)
#pragma unroll
      for (int s = 0; s < 2; s++) pf[kb][s] = pack8(S[kb], s);
#pragma unroll
    for (int gi = 0; gi < 4; gi++) {
      const int kb = gi >> 1, sx = gi & 1;
      if (gi + 1 < 4) {
        const int kb2 = (gi + 1) >> 1, s2 = (gi + 1) & 1;
#pragma unroll
        for (int d = 0; d < ND; d++) {
          const bf16x8 t = *(const bf16x8*)(sV + (d * 32 + r) * VS + kb2 * 32 + 16 * s2 + 8 * hh);
          if (gi & 1) vfa[d] = t; else vfb[d] = t;
        }
      }
#pragma unroll
      for (int d = 0; d < ND; d++) O[d] = MFMA((gi & 1) ? vfb[d] : vfa[d], pf[kb][sx], O[d]);
      }
    if (kt + 1 < nkt) sstore(buf ^ 1);
    __syncthreads();
  }
  lsum_out = l_run + __shfl_xor(l_run, 32);
}

DI void mla_item(const Params& p, int hb, int qt, char* smem) {
  const int bl = hb >> 3, hd = hb & 7;
  const int nkt = qt < 2 ? CTX / 64 : LP / 64;
  f32x16 O[2];
  float l;
  flash_core<96, 64>(p.Qm + ((size_t)hb * LP + qt * 128) * 96, p.Km + (size_t)hb * LP * 96, p.Vtm + (size_t)hb * 64 * LP, nkt, O, l, smem);
  const int lane = tidx() & 63, w = tidx() >> 6, r = lane & 31, hh = lane >> 5;
  const float inv = 1.f / l;
  bf16_t* dst = p.ymla + ((size_t)(bl * LP + qt * 128 + w * 32 + r)) * 512 + hd * 64;
#pragma unroll
  for (int d = 0; d < 2; d++)
#pragma unroll
    for (int gq = 0; gq < 4; gq++) {
      u32x2 u;
      u.x = pk2(O[d][4 * gq + 0] * inv, O[d][4 * gq + 1] * inv);
      u.y = pk2(O[d][4 * gq + 2] * inv, O[d][4 * gq + 3] * inv);
      *(u32x2*)(dst + d * 32 + 8 * gq + 4 * hh) = u;
    }
}

DI void diff_item(const Params& p, int layer, float lam_init, int hb, int qt, char* smem) {
  const int bl = hb >> 2, hd = hb & 3;
  const int nkt = qt < 2 ? CTX / 64 : LP / 64;
  const int tid = tidx(), lane = tid & 63, w = tid >> 6, r = lane & 31, hh = lane >> 5;
  const float* dl = p.diff_lambda + layer * 256;
  float s1 = 0.f, s2 = 0.f;
  for (int j = 0; j < 64; j++) {
    s1 += dl[j] * dl[64 + j];
    s2 += dl[128 + j] * dl[192 + j];
  }
  const float lam = expf(s1) - expf(s2) + lam_init;
  float4* st = (float4*)(p.stash + ((size_t)blockIdx.x * 256 + tid) * 64);
  f32x16 O[4];
  float l;
  flash_core<64, 128>(p.dq + ((size_t)(hb * 2 + 0) * LP + qt * 128) * 64, p.dk + (size_t)(hb * 2 + 0) * LP * 64,
                      p.dvt + (size_t)hb * 128 * LP, nkt, O, l, smem);
  {
    const float inv = 1.f / l;
#pragma unroll
    for (int d = 0; d < 4; d++)
#pragma unroll
      for (int gq = 0; gq < 4; gq++)
        st[d * 4 + gq] = make_float4(O[d][4 * gq] * inv, O[d][4 * gq + 1] * inv, O[d][4 * gq + 2] * inv, O[d][4 * gq + 3] * inv);
  }
  flash_core<64, 128>(p.dq + ((size_t)(hb * 2 + 1) * LP + qt * 128) * 64, p.dk + (size_t)(hb * 2 + 1) * LP * 64,
                      p.dvt + (size_t)hb * 128 * LP, nkt, O, l, smem);
  const float inv2 = lam / l;
  float ss = 0.f;
#pragma unroll
  for (int d = 0; d < 4; d++)
#pragma unroll
    for (int gq = 0; gq < 4; gq++) {
      const float4 sv = st[d * 4 + gq];
      const float o0 = sv.x - O[d][4 * gq + 0] * inv2, o1 = sv.y - O[d][4 * gq + 1] * inv2;
      const float o2 = sv.z - O[d][4 * gq + 2] * inv2, o3 = sv.w - O[d][4 * gq + 3] * inv2;
      O[d][4 * gq + 0] = o0; O[d][4 * gq + 1] = o1; O[d][4 * gq + 2] = o2; O[d][4 * gq + 3] = o3;
      ss += o0 * o0 + o1 * o1 + o2 * o2 + o3 * o3;
    }
  ss += __shfl_xor(ss, 32);
  const float rs = rsqrtf(ss * (1.f / 128.f) + 1e-6f) * (1.f - lam_init);
  const float* sub = p.diff_subln + layer * 128;
  bf16_t* dst = p.ydiff + ((size_t)(bl * LP + qt * 128 + w * 32 + r)) * 512 + hd * 128;
#pragma unroll
  for (int d = 0; d < 4; d++)
#pragma unroll
    for (int gq = 0; gq < 4; gq++) {
      const int dv = d * 32 + 8 * gq + 4 * hh;
      const float4 sg = *(const float4*)(sub + dv);
      u32x2 u;
      u.x = pk2(O[d][4 * gq + 0] * rs * sg.x, O[d][4 * gq + 1] * rs * sg.y);
      u.y = pk2(O[d][4 * gq + 2] * rs * sg.z, O[d][4 * gq + 3] * rs * sg.w);
      *(u32x2*)(dst + dv) = u;
    }
}

constexpr int HQS = 136, HTS = 40;
struct HgLds {
  bf16_t *sQ, *sK, *sKT, *sVT;
  float *sER, *sA1, *sA2, *sTot;
};
DI HgLds hg_lds(char* smem) {
  HgLds L;
  L.sQ = (bf16_t*)smem;
  L.sK = L.sQ + 32 * HQS;
  L.sKT = L.sK + 32 * HQS;
  L.sVT = L.sKT + 128 * HTS;
  L.sER = (float*)(L.sVT + 128 * HTS);
  L.sA1 = L.sER + 128;
  L.sA2 = L.sA1 + 128;
  L.sTot = L.sA2 + 128;
  return L;
}
DI float hg_lower_bound(const Params& p, int dir, int layer, int col) {
  const float* lg = p.lb_logits + (size_t)dir * DEPTH * 512 + col;
  const float v0 = lg[0], v1 = lg[512], v2 = lg[1024], v3 = lg[1536];
  const float mx = fmaxf(fmaxf(v0, v1), fmaxf(v2, v3));
  const float e0 = expf(v0 - mx), e1 = expf(v1 - mx), e2 = expf(v2 - mx), e3 = expf(v3 - mx);
  const float inv = 1.f / (e0 + e1 + e2 + e3);
  float acc = 0.f;
  if (layer >= 1) acc += e1;
  if (layer >= 2) acc += e2;
  if (layer >= 3) acc += e3;
  return acc * inv;
}
DI float hg_stage(const Params& p, const HgLds& L, int dir, int hd, size_t row0, int rstep) {
  const int tid = tidx(), k = tid & 127, half = tid >> 7;
  const size_t cofs = hd * 128 + k;
  const bf16_t* gsrc = (dir ? p.gb : p.gf) + cofs;
  const bf16_t* ksrc = (dir ? p.zb : p.zf) + cofs;
  float bc[16];
  unsigned kq[16];
  bf16_t vr[16];
  float cum = 0.f;
#pragma unroll
  for (int uu = 0; uu < 16; uu++) {
    const int u = half * 16 + uu;
    const size_t row = row0 + (size_t)((long)rstep * u);
    const float gl = bf2f(gsrc[row * 512]);
    kq[uu] = (unsigned)ksrc[row * 512] | ((unsigned)p.hq[row * 512 + cofs] << 16);
    vr[uu] = p.hi[row * 512 + cofs];
    cum += gl;
    bc[uu] = cum;
  }
  __syncthreads();
  if (half == 0) L.sTot[k] = cum;
  __syncthreads();
  const float rref = L.sTot[k];
  float blast = 0.f;
  if (half == 1) {
    blast = rref + cum;
    L.sER[k] = __expf(rref);
    L.sA1[k] = __expf(blast);
    L.sA2[k] = __expf(blast - rref);
  }
  const float off = half ? 0.f : -rref;
#pragma unroll
  for (int uu = 0; uu < 16; uu++) {
    const int u = half * 16 + uu;
    const float e = fminf(fmaxf(bc[uu] + off, -80.f), 80.f);
    const float kvv = __uint_as_float(kq[uu] << 16);
    const float q = __uint_as_float(kq[uu] & 0xffff0000u);
    const float ee = __expf(e);
    const bf16_t kt = f2bf(kvv * __frcp_rn(ee));
    L.sQ[u * HQS + k] = f2bf(q * ee);
    L.sK[u * HQS + k] = kt;
    L.sKT[k * HTS + u] = kt;
    L.sVT[k * HTS + u] = vr[uu];
    if ((uu & 3) == 3) __builtin_amdgcn_sched_barrier(0);
  }
  __syncthreads();
  return blast;
}
DI void hg_update(const HgLds& L, f32x16 (&S)[4]) {
  const int lane = tidx() & 63, w = tidx() >> 6, r = lane & 31, hh = lane >> 5;
#pragma unroll
  for (int dkt = 0; dkt < 4; dkt++) {
    f32x16 T;
    zero16(T);
#pragma unroll
    for (int st = 0; st < 2; st++) {
      const bf16x8 a = *(const bf16x8*)(L.sKT + (dkt * 32 + r) * HTS + st * 16 + 8 * hh);
      const bf16x8 b = *(const bf16x8*)(L.sVT + (w * 32 + r) * HTS + st * 16 + 8 * hh);
      T = MFMA(a, b, T);
    }
#pragma unroll
    for (int gq = 0; gq < 4; gq++) {
      const int dk = dkt * 32 + 8 * gq + 4 * hh;
      const float4 a1 = *(const float4*)(L.sA1 + dk);
      const float4 a2 = *(const float4*)(L.sA2 + dk);
      S[dkt][4 * gq + 0] = a1.x * S[dkt][4 * gq + 0] + a2.x * T[4 * gq + 0];
      S[dkt][4 * gq + 1] = a1.y * S[dkt][4 * gq + 1] + a2.y * T[4 * gq + 1];
      S[dkt][4 * gq + 2] = a1.z * S[dkt][4 * gq + 2] + a2.z * T[4 * gq + 2];
      S[dkt][4 * gq + 3] = a1.w * S[dkt][4 * gq + 3] + a2.w * T[4 * gq + 3];
    }
  }
}
DI void hg_output(const HgLds& L, const f32x16 (&S)[4], f32x16& O) {
  const int lane = tidx() & 63, w = tidx() >> 6, r = lane & 31, hh = lane >> 5;
  f32x16 X;
  zero16(X);
#pragma unroll
  for (int ks = 0; ks < 8; ks++) {
    const bf16x8 a = *(const bf16x8*)(L.sK + r * HQS + ks * 16 + 8 * hh);
    const bf16x8 b = *(const bf16x8*)(L.sQ + r * HQS + ks * 16 + 8 * hh);
    X = MFMA(a, b, X);
  }
#pragma unroll
  for (int i = 0; i < 16; i++)
    if (crow(i, hh) > r) X[i] = 0.f;
  zero16(O);
#pragma unroll
  for (int st = 0; st < 2; st++) {
    const bf16x8 pf = pack8(X, st);
    const bf16_t* vp = L.sVT + (w * 32 + r) * HTS + 16 * st + 4 * hh;
    const bf16x8 vf = cat4(*(const bf16x4*)vp, *(const bf16x4*)(vp + 8));
    O = MFMA(vf, pf, O);
  }
#pragma unroll
  for (int dkt = 0; dkt < 4; dkt++) {
    f32x16 Ss;
#pragma unroll
    for (int gq = 0; gq < 4; gq++) {
      const float4 er = *(const float4*)(L.sER + dkt * 32 + 8 * gq + 4 * hh);
      Ss[4 * gq + 0] = S[dkt][4 * gq + 0] * er.x;
      Ss[4 * gq + 1] = S[dkt][4 * gq + 1] * er.y;
      Ss[4 * gq + 2] = S[dkt][4 * gq + 2] * er.z;
      Ss[4 * gq + 3] = S[dkt][4 * gq + 3] * er.w;
    }
#pragma unroll
    for (int st = 0; st < 2; st++) {
      const bf16x8 xs = pack8(Ss, st);
      const bf16_t* qp = L.sQ + r * HQS + dkt * 32 + 16 * st + 4 * hh;
      const bf16x8 qb = cat4(*(const bf16x4*)qp, *(const bf16x4*)(qp + 8));
      O = MFMA(xs, qb, O);
    }
  }
}
DI int hg_pos(int dir, int rng) { return dir == 0 ? rng : (rng == 0 ? 0 : NRNG - rng); }

DI void hg1_item(const Params& p, int layer, int sq, int rng, char* smem) {
  const HgLds L = hg_lds(smem);
  const int dir = sq & 1, hd = (sq >> 1) & 3, bl = sq >> 3;
  const int tid = tidx(), lane = tid & 63, w = tid >> 6, r = lane & 31, hh = lane >> 5;
  f32x16 S[4];
#pragma unroll
  for (int i = 0; i < 4; i++) zero16(S[i]);
  float btot = 0.f;
  const size_t rbase = (size_t)bl * LP + rng * 256;
  for (int c = 0; c < 8; c++) {
    const size_t row0 = dir ? rbase + 255 - c * 32 : rbase + c * 32;
    btot += hg_stage(p, L, dir, hd, row0, dir ? -1 : 1);
    hg_update(L, S);
  }
  const int pos = hg_pos(dir, rng);
  float* dst = p.hgst + ((size_t)sq * NRNG + pos) * 16384;
#pragma unroll
  for (int dkt = 0; dkt < 4; dkt++)
#pragma unroll
    for (int i = 0; i < 16; i++) dst[(dkt * 32 + crow(i, hh)) * 128 + w * 32 + r] = S[dkt][i];
  if (tid >= 128) p.hgdec[((size_t)sq * NRNG + pos) * 128 + (tid & 127)] = __expf(btot);
}
DI void hg2_item(const Params& p, int sq, int sl) {
  const int e = sl * 256 + tidx();
  const int dk = e >> 7;
  float* base = p.hgst + (size_t)sq * NRNG * 16384 + e;
  const float* dec = p.hgdec + (size_t)sq * NRNG * 128 + dk;
  float u[NRNG], dcy[NRNG];
#pragma unroll
  for (int pos = 0; pos < NRNG; pos++) {
    u[pos] = base[(size_t)pos * 16384];
    dcy[pos] = dec[pos * 128];
  }
  float S = 0.f;
#pragma unroll
  for (int pos = 0; pos < NRNG; pos++) {
    const float o = S;
    S = dcy[pos] * S + u[pos];
    u[pos] = o;
  }
#pragma unroll
  for (int pos = 0; pos < NRNG; pos++) base[(size_t)pos * 16384] = u[pos];
}
DI void hg3_item(const Params& p, int layer, int bh, int rng, char* smem) {
  const HgLds L = hg_lds(smem);
  const int hd = bh & 3, bl = bh >> 2;
  const int tid = tidx(), lane = tid & 63, w = tid >> 6, r = lane & 31, hh = lane >> 5;
  const size_t rbase = (size_t)bl * LP + rng * 256;
#pragma unroll 1
  for (int dir = 0; dir < 2; dir++) {
    const int sq = bh * 2 + dir;
    const int pos = hg_pos(dir, rng);
    const float* src = p.hgst + ((size_t)sq * NRNG + pos) * 16384;
    f32x16 S[4];
#pragma unroll
    for (int dkt = 0; dkt < 4; dkt++)
#pragma unroll
      for (int i = 0; i < 16; i++) S[dkt][i] = src[(dkt * 32 + crow(i, hh)) * 128 + w * 32 + r];
    if (dir == 1) __syncthreads();
#pragma unroll 1
    for (int c = 0; c < 8; c++) {
      const size_t row0 = dir ? rbase + 255 - c * 32 : rbase + c * 32;
      const size_t trow = dir ? row0 - r : row0 + r;
      float* od = p.osum + trow * 512 + hd * 128 + w * 32;
      float4 prev[4];
      if (dir == 1) {
#pragma unroll
        for (int gq = 0; gq < 4; gq++) prev[gq] = *(const float4*)(od + 8 * gq + 4 * hh);
      }
      hg_stage(p, L, dir, hd, row0, dir ? -1 : 1);
      f32x16 O;
      hg_output(L, S, O);
#pragma unroll
      for (int gq = 0; gq < 4; gq++) {
        float4 v = make_float4(O[4 * gq + 0], O[4 * gq + 1], O[4 * gq + 2], O[4 * gq + 3]);
        if (dir == 1) {
          v.x += prev[gq].x; v.y += prev[gq].y; v.z += prev[gq].z; v.w += prev[gq].w;
        }
        *(float4*)(od + 8 * gq + 4 * hh) = v;
      }
      if (c < 7) hg_update(L, S);
    }
  }
  __syncthreads();
  const float* gn = p.hg_norm + layer * 128;
  const float g0 = gn[2 * lane], g1 = gn[2 * lane + 1];
#pragma unroll 1
  for (int t0 = w; t0 < 256; t0 += 32) {
    float2 v[8];
    unsigned og[8];
#pragma unroll
    for (int q = 0; q < 8; q++) {
      const size_t row = rbase + t0 + 4 * q;
      v[q] = *(const float2*)(p.osum + row * 512 + hd * 128 + 2 * lane);
      og[q] = *(const unsigned*)(p.hog + row * 512 + hd * 128 + 2 * lane);
    }
#pragma unroll
    for (int q = 0; q < 8; q++) {
      const size_t row = rbase + t0 + 4 * q;
      float ss = v[q].x * v[q].x + v[q].y * v[q].y;
#pragma unroll
      for (int o = 32; o >= 1; o >>= 1) ss += __shfl_xor(ss, o);
      const float rs = rsqrtf(ss * (1.f / 128.f) + 1e-6f);
      const float o0 = __uint_as_float(og[q] << 16), o1 = __uint_as_float(og[q] & 0xffff0000u);
      *(unsigned*)(p.yhg + row * 512 + hd * 128 + 2 * lane) = pk2(v[q].x * rs * g0 * silu_f(o0), v[q].y * rs * g1 * silu_f(o1));
    }
  }
}

constexpr int MERGE_FULL = 1024, MERGE_ITEMS = MERGE_FULL + 64;
DI void merge_half_item(const Params& p, const bf16_t* hb, int layer, int mti, int nti, char* smem) {

  bf16_t* sA = (bf16_t*)smem;
  bf16_t* sB = sA + 128 * 72;
  const int m0 = mti * 128, n0 = nti * 64;
  const int lane = tidx() & 63, w = tidx() >> 6, wm = w >> 1, wn = w & 1, r = lane & 31, hh = lane >> 5;
  f32x16 mac[2];
  zero16(mac[0]);
  zero16(mac[1]);
  const int col = n0 + wn * 32 + r;
#pragma unroll 1
  for (int i = 0; i < 3; i++) {
    f32x16 ga[2][1], ba[2][1];
    zero16(ga[0][0]);
    zero16(ga[1][0]);
    gemm_core<1>(hb + (size_t)m0 * D, D, p.wg_t + ((size_t)i * D + n0) * D, D, D, ga, sA, sB);
    const float bg = p.b_gate[(layer * 3 + i) * D + col];
#pragma unroll
    for (int mt = 0; mt < 2; mt++)
#pragma unroll
      for (int j = 0; j < 16; j++) ga[mt][0][j] = sigmoid_f(ga[mt][0][j] + bg);
    zero16(ba[0][0]);
    zero16(ba[1][0]);
    const bf16_t* Y = i == 0 ? p.ymla : i == 1 ? p.yhg : p.ydiff;
    gemm_core<1>(Y + (size_t)m0 * 512, 512, p.wb_t + ((size_t)i * D + n0) * 512, 512, 512, ba, sA, sB);
#pragma unroll
    for (int mt = 0; mt < 2; mt++)
#pragma unroll
      for (int j = 0; j < 16; j++) mac[mt][j] += ga[mt][0][j] * ba[mt][0][j];
  }
#pragma unroll
  for (int mt = 0; mt < 2; mt++)
#pragma unroll
    for (int j = 0; j < 16; j++) {
      const int row = m0 + wm * 64 + mt * 32 + crow(j, hh);
      p.mbuf[(size_t)row * D + col] = f2bf(mac[mt][j]);
    }
}

DI void merge_item(const Params& p, const bf16_t* hb, int layer, int it, char* smem) {
  bf16_t* sA = (bf16_t*)smem;
  bf16_t* sB = sA + 128 * 72;
  int mti, nti;
  if (it >= MERGE_FULL) {
    patch_decode(MERGE_FULL + ((it - MERGE_FULL) >> 1), MT, 8, mti, nti);
    merge_half_item(p, hb, layer, mti, nti * 2 + ((it - MERGE_FULL) & 1), smem);
    return;
  }
  patch_decode(it, MT, 8, mti, nti);
  const int m0 = mti * 128, n0 = nti * 128;
  const int lane = tidx() & 63, w = tidx() >> 6, wm = w >> 1, wn = w & 1, r = lane & 31, hh = lane >> 5;
  unsigned mpk[2][2][8];
#pragma unroll
  for (int a = 0; a < 2; a++)
#pragma unroll
    for (int b = 0; b < 2; b++)
#pragma unroll
      for (int j = 0; j < 8; j++) mpk[a][b][j] = 0u;
#pragma unroll 1
  for (int i = 0; i < 3; i++) {
    unsigned gpk[2][2][8];
    {
      f32x16 ga[2][2];
#pragma unroll
      for (int a = 0; a < 2; a++)
#pragma unroll
        for (int b = 0; b < 2; b++) zero16(ga[a][b]);
      gemm_core1(hb + (size_t)m0 * D, D, p.wg_t + ((size_t)i * D + n0) * D, D, D, ga, sA, sB);
#pragma unroll
      for (int nt = 0; nt < 2; nt++) {
        const float bg = p.b_gate[(layer * 3 + i) * D + n0 + wn * 64 + nt * 32 + r];
#pragma unroll
        for (int mt = 0; mt < 2; mt++)
#pragma unroll
          for (int j = 0; j < 8; j++)
            gpk[mt][nt][j] = pk2(sigmoid_f(ga[mt][nt][2 * j] + bg), sigmoid_f(ga[mt][nt][2 * j + 1] + bg));
      }
    }
    f32x16 ba[2][2];
#pragma unroll
    for (int a = 0; a < 2; a++)
#pragma unroll
      for (int b = 0; b < 2; b++) zero16(ba[a][b]);
    const bf16_t* Y = i == 0 ? p.ymla : i == 1 ? p.yhg : p.ydiff;
    gemm_core1(Y + (size_t)m0 * 512, 512, p.wb_t + ((size_t)i * D + n0) * 512, 512, 512, ba, sA, sB);
#pragma unroll
    for (int mt = 0; mt < 2; mt++)
#pragma unroll
      for (int nt = 0; nt < 2; nt++)
#pragma unroll
        for (int j = 0; j < 8; j++) {
          const unsigned u = gpk[mt][nt][j], m = mpk[mt][nt][j];
          const float lo = __uint_as_float(m << 16) + __uint_as_float(u << 16) * ba[mt][nt][2 * j];
          const float hi = __uint_as_float(m & 0xffff0000u) + __uint_as_float(u & 0xffff0000u) * ba[mt][nt][2 * j + 1];
          mpk[mt][nt][j] = pk2(lo, hi);
        }
  }
#pragma unroll
  for (int mt = 0; mt < 2; mt++)
#pragma unroll
    for (int nt = 0; nt < 2; nt++)
#pragma unroll
      for (int j = 0; j < 16; j++) {
        const int row = m0 + wm * 64 + mt * 32 + crow(j, hh);
        const unsigned m = mpk[mt][nt][j >> 1];
        p.mbuf[(size_t)row * D + n0 + wn * 64 + nt * 32 + r] = (bf16_t)((j & 1) ? (m >> 16) : (m & 0xffffu));
      }
}

constexpr int RES_FULL = 1024, RES_ITEMS = RES_FULL + 64;
DI void resid_item(const Params& p, int g, int layer, int it, const bf16_t* A, int K, const bf16_t* Wt, int gate_off,
                   char* smem) {
  bf16_t* sA = (bf16_t*)smem;
  bf16_t* sB = sA + 128 * 72;
  const int lane = tidx() & 63, w = tidx() >> 6, wm = w >> 1, wn = w & 1, r = lane & 31, hh = lane >> 5;
  if (it >= RES_FULL) {
    int mti, nti;
    patch_decode(RES_FULL + ((it - RES_FULL) >> 1), MT, 8, mti, nti);
    const int m0 = mti * 128, n0 = nti * 128 + ((it - RES_FULL) & 1) * 64;
    f32x16 acc[2][1];
    zero16(acc[0][0]);
    zero16(acc[1][0]);
    gemm_core<1>(A + (size_t)m0 * K, K, Wt + (size_t)n0 * K, K, K, acc, sA, sB);
    const float* md = mod_row(p, g, layer, m0) + gate_off;
    const float* xs = xsrc_row(p, g, gate_off == 2 * D ? layer : 1, m0);
    float* xd = xdst_row(p, g, m0);
    const int col = n0 + wn * 32 + r;
    const float gt = md[col];
#pragma unroll
    for (int mt = 0; mt < 2; mt++) {
#pragma unroll
      for (int i = 0; i < 16; i++) {
        const int ro = (wm * 64 + mt * 32 + crow(i, hh)) * D + col;
        xd[ro] = ALPHA * xs[ro] + gt * acc[mt][0][i];
      }
      __builtin_amdgcn_sched_barrier(0);
    }
    return;
  }
  int mti, nti;
  patch_decode(it, MT, 8, mti, nti);
  const int m0 = mti * 128, n0 = nti * 128;
  f32x16 acc[2][2];
#pragma unroll
  for (int a = 0; a < 2; a++)
#pragma unroll
    for (int b = 0; b < 2; b++) zero16(acc[a][b]);
  gemm_core<2>(A + (size_t)m0 * K, K, Wt + (size_t)n0 * K, K, K, acc, sA, sB);
  const float* md = mod_row(p, g, layer, m0) + gate_off;
  const float* xs = xsrc_row(p, g, gate_off == 2 * D ? layer : 1, m0);
  float* xd = xdst_row(p, g, m0);
#pragma unroll
  for (int nt = 0; nt < 2; nt++) {
    const int col = n0 + wn * 64 + nt * 32 + r;
    const float gt = md[col];
#pragma unroll
    for (int mt = 0; mt < 2; mt++) {
#pragma unroll
      for (int i = 0; i < 16; i++) {
        const int ro = (wm * 64 + mt * 32 + crow(i, hh)) * D + col;
        xd[ro] = ALPHA * xs[ro] + gt * acc[mt][nt][i];
      }
      __builtin_amdgcn_sched_barrier(0);
    }
  }
}

DI void ffn1_item(const Params& p, const bf16_t* hb, int it, char* smem) {
  bf16_t* sA = (bf16_t*)smem;
  bf16_t* sB = sA + 128 * 72;
  int mti, nti;
  patch_decode(it, MT, 22, mti, nti);
  const int m0 = mti * 128, n0 = nti * 256;
  f32x16 acc[2][4];
#pragma unroll
  for (int a = 0; a < 2; a++)
#pragma unroll
    for (int b = 0; b < 4; b++) zero16(acc[a][b]);
  gemm_core_wide(hb + (size_t)m0 * D, D, p.wff1_t + (size_t)n0 * D, D, D, acc, sA, sB);
  const int lane = tidx() & 63, w = tidx() >> 6, wm = w >> 1, wn = w & 1, r = lane & 31, hh = lane >> 5;
#pragma unroll
  for (int pr = 0; pr < 2; pr++) {
    const int col = nti * 128 + wn * 64 + pr * 32 + r;
#pragma unroll
    for (int mt = 0; mt < 2; mt++)
#pragma unroll
      for (int i = 0; i < 16; i++) {
        const int row = m0 + wm * 64 + mt * 32 + crow(i, hh);
        p.hid[(size_t)row * FFH + col] = f2bf(silu_f(acc[mt][2 * pr][i]) * acc[mt][2 * pr + 1][i]);
      }
  }
}

#define XCD_LOOP(N, L)                                                     \
  for (int k_ = 0, nb8_ = nblk >> 3; k_ * 8 * nb8_ < (N); k_++)            \
    for (int L = (k_ * 8 + (bid & 7)) * nb8_ + (bid >> 3), o_ = 1; o_ && L < (N); o_ = 0)
#define XCD_LOOP_SPREAD(N, L)                                                                          \
  for (int ph_ = 0, nf_ = ((N) / nblk) * nblk; ph_ < 2; ph_++)                                          \
    for (int k_ = 0, nb8_ = nblk >> 3; ph_ == 0 ? (k_ * 8 * nb8_ < nf_) : (k_ == 0); k_++)              \
      for (int L = ph_ == 0 ? (k_ * 8 + (bid & 7)) * nb8_ + (bid >> 3) : nf_ + bid, o_ = 1;             \
           o_ && L < (ph_ == 0 ? nf_ : (N)); o_ = 0)
#define XB_TMO      128
#define XB_XCNT(j)  (256  + 64 * (j))
#define XB_XSUB(j)  (1280 + 64 * (j))
#define XB_XGEN(j)  (2304 + 64 * (j))
#define XB_TOP      3328
#define XB_TOPGEN   3392
#define XCD_BAR_WORDS 3456
#define XB_SPIN_CAP (1u << 20)
#define LAS __attribute__((address_space(3)))
DI unsigned xb_ld(unsigned* p) { return __hip_atomic_load(p, __ATOMIC_RELAXED, __HIP_MEMORY_SCOPE_AGENT); }
DI unsigned xb_add(unsigned* p, unsigned v) { return __hip_atomic_fetch_add(p, v, __ATOMIC_RELAXED, __HIP_MEMORY_SCOPE_AGENT); }
DI unsigned xb_xcc_id() { return (unsigned)__builtin_amdgcn_s_getreg((3 << 11) | 20) & 0xFu; }
#define XB_SPIN(cond, bar) do { unsigned _sp = 0; while (cond) { __builtin_amdgcn_s_sleep(1); \
    if ((++_sp & 255u) == 0u) { if (xb_ld(&(bar)[XB_TMO])) break; if (_sp > XB_SPIN_CAP) { atomicAdd(&(bar)[XB_TMO], 1u); break; } } } } while (0)
struct XcdBarrier {
  unsigned* bar;
  unsigned x;
  volatile LAS unsigned* st;
};
DI XcdBarrier xcd_barrier_post(unsigned* bar, volatile LAS unsigned* st) {
  XcdBarrier b;
  b.bar = bar;
  b.x = xb_xcc_id();
  b.st = st;
  if (threadIdx.x == 0) (void)xb_add(&bar[XB_XCNT(b.x)], 1u);
  return b;
}
DI void xcd_barrier_complete(unsigned* bar, unsigned x, unsigned& nloc, unsigned& nx) {
  const unsigned G = gridDim.x * gridDim.y * gridDim.z;
  unsigned sum, cnt, mine, sp = 0u;
  for (;;) {
    sum = 0u; cnt = 0u; mine = 0u;
#pragma unroll
    for (unsigned j = 0; j < 16; ++j) {
      const unsigned c = xb_ld(&bar[XB_XCNT(j)]);
      sum += c;
      cnt += (c > 0u) ? 1u : 0u;
      mine = (j == x) ? c : mine;
    }
    if (sum == G) break;
    __builtin_amdgcn_s_sleep(1);
    if ((++sp & 255u) == 0u) {
      if (xb_ld(&bar[XB_TMO])) break;
      if (sp > XB_SPIN_CAP) { atomicAdd(&bar[XB_TMO], 1u); break; }
    }
  }
  nloc = mine > 0u ? mine : 1u;
  nx = cnt > 0u ? cnt : 1u;
}
DI void xcd_barrier(const XcdBarrier& b) {
  asm volatile("s_waitcnt vmcnt(0)" ::: "memory");
  __syncthreads();
  if (threadIdx.x == 0) {
    unsigned* bar = b.bar;
    __builtin_amdgcn_s_waitcnt(0);
    unsigned nloc = b.st[0], nx = b.st[1];
    if (nloc == 0u) {
      xcd_barrier_complete(bar, b.x, nloc, nx);
      b.st[0] = nloc;
      b.st[1] = nx;
    }
    const unsigned old = xb_add(&bar[XB_XSUB(b.x)], 1u);
    const unsigned gen = old / nloc;
    if (old + 1u == (gen + 1u) * nloc) {
      __builtin_amdgcn_fence(__ATOMIC_RELEASE, "agent");
      asm volatile("s_waitcnt vmcnt(0)" ::: "memory");
      const unsigned og = xb_add(&bar[XB_TOP], 1u);
      const unsigned tg = og / nx;
      if (og + 1u == (tg + 1u) * nx) xb_add(&bar[XB_TOPGEN], 1u);
      else XB_SPIN(xb_ld(&bar[XB_TOPGEN]) == tg, bar);
      __builtin_amdgcn_fence(__ATOMIC_ACQUIRE, "agent");
      xb_add(&bar[XB_XGEN(b.x)], 1u);
      asm volatile("s_waitcnt vmcnt(0)" ::: "memory");
    } else {
      XB_SPIN(xb_ld(&bar[XB_XGEN(b.x)]) == gen, bar);
      __builtin_amdgcn_fence(__ATOMIC_ACQUIRE, "agent");
      asm volatile("s_waitcnt vmcnt(0)" ::: "memory");
    }
  }
  __syncthreads();
}

DI void dep_publish(unsigned* c1, unsigned* c2) {
  asm volatile("s_waitcnt vmcnt(0)" ::: "memory");
  __syncthreads();
  if (threadIdx.x == 0) {
    __builtin_amdgcn_fence(__ATOMIC_RELEASE, "agent");
    asm volatile("s_waitcnt vmcnt(0)" ::: "memory");
    xb_add(c1, 1u);
    if (c2) xb_add(c2, 1u);
  }
}
DI void dep_wait(unsigned* c, unsigned target, unsigned* bar) {
  if (threadIdx.x == 0) {
    XB_SPIN(xb_ld(c) < target, bar);
    __builtin_amdgcn_fence(__ATOMIC_ACQUIRE, "agent");
    asm volatile("s_waitcnt vmcnt(0)" ::: "memory");
  }
  __syncthreads();
}

__global__ void __launch_bounds__(256, 2) mega_kernel(Params p, float li0, float li1, float li2, float li3, int repD, int repG, int repH) {
  __shared__ __attribute__((aligned(16))) char smem[SMEM_BYTES];
  cg::grid_group grid = cg::this_grid();
  const int nblk = gridDim.x, bid = blockIdx.x;
  __shared__ uint4 xb_words;
  if (threadIdx.x == 0) xb_words = make_uint4(0u, 0u, 0u, 0u);
  if (bid == 0) {
    for (int e = tidx(); e < XCD_BAR_WORDS; e += 256) p.xbar[e] = 0u;
    for (int e = tidx(); e < NGRP * DEPTH * 512; e += 256) p.dep[e] = 0u;
    p.qctr[tidx()] = 0u;
  }
  __syncthreads();
  for (int it = bid; it < 384 + CV_TOTAL; it += nblk) {
    if (it < 384) mod_item(p, it, smem);
    else conv_item(p, 0, it - 384, smem);
  }
  grid.sync();
  const XcdBarrier xb = xcd_barrier_post(p.xbar, (volatile LAS unsigned*)&xb_words);
  const int rpb = (TG + nblk - 1) / nblk;
  const int rp0 = min(TG, bid * rpb), rp1 = min(TG, rp0 + rpb);
#pragma unroll 1
  for (int g = 0; g < NGRP; g++) {
    rowpass_rows(p, p.h + (size_t)g * TG * D, g, rp0, rp1, 0, 0, nullptr, nullptr, 0, 0, true);
  }
  xcd_barrier(xb);
#pragma unroll 1
  for (int layer = 0; layer < DEPTH; layer++) {
#pragma unroll 1
    for (int g = 0; g < NGRP; g++) {
      bf16_t* hb = p.h + (size_t)g * TG * D;
      const float lam_init = layer == 0 ? li0 : layer == 1 ? li1 : layer == 2 ? li2 : li3;
#pragma unroll 1
      for (int rep = 0; rep < repG; rep++)
      XCD_LOOP_SPREAD(MT * 36, it) inproj_item(p, hb, layer, it, smem);
      xcd_barrier(xb);
#pragma unroll 1
      for (int rep = 1; rep < repD; rep++) xcd_barrier(xb);
      {
        constexpr int N2 = MT * 6, N3 = MT * 8, N4 = MT;
        unsigned* ctr = p.qctr + 64 + (g * DEPTH + layer);
        int* sNext = (int*)(smem + SMEM_BYTES - 16);
        for (;;) {
          __syncthreads();
          if (tidx() == 0) *sNext = (int)atomicAdd(ctr, 1u);
          __syncthreads();
          const int it = *sNext;
          if (it >= N2 + N3 + N4) break;
          if (it < N4) kpe_item(p, it);
          else if (it < N4 + N2) upq_item(p, it - N4, smem);
          else upkv_item(p, it - N4 - N2, smem);
        }
      }
      xcd_barrier(xb);
      {
        static_assert(GB * 4 == 8 && GB * 8 == 16, "attention queue assumes 8 diff heads / 16 MLA heads per group");
        const int xhome = (int)(xb.x & 7u);
        int* sNext = (int*)(smem + SMEM_BYTES - 16);
        constexpr int QA = 32, QB_ = QA + 2 * NRNG, QC = QB_ + 34, QD = QC + 128, QE = QD + NRNG, QF = QE + 132;
#pragma unroll 1
        for (int qd = 0; qd < 8; qd++) {
          const int xq = (xhome + qd) & 7;
          unsigned* dep = p.dep + (g * DEPTH + layer) * 512 + xq * 8;
          unsigned* ctr = p.qctr + (g * DEPTH + layer) * 8 + xq;
          bool rdy1a = false, rdy1b = false, rdy2 = false;
          for (;;) {
            __syncthreads();
            if (tidx() == 0) *sNext = (int)atomicAdd(ctr, 1u);
            __syncthreads();
            const int it = *sNext;
            if (it >= QF) break;
            if (it < QA) {
              diff_item(p, layer, lam_init, xq, (it + 2) % 66, smem);
            } else if (it < QB_) {
              const int j = it - QA, dir = j / NRNG, rng = j % NRNG;
              hg1_item(p, layer, xq * 2 + dir, rng, smem);
              dep_publish(dep + dir, nullptr);
            } else if (it < QC) {
              diff_item(p, layer, lam_init, xq, (it - QB_ + QA + 2) % 66, smem);
            } else if (it < QD) {
              const int j = it - QC, dir = j >> 6, sl = j & 63;
              if (!(dir ? rdy1b : rdy1a)) {
                dep_wait(dep + dir, (unsigned)NRNG, p.xbar);
                if (dir) rdy1b = true; else rdy1a = true;
              }
              hg2_item(p, xq * 2 + dir, sl);
              dep_publish(dep + 2, nullptr);
            } else if (it < QE) {
              if (!rdy2) {
                dep_wait(dep + 2, 128u, p.xbar);
                rdy2 = true;
              }
              hg3_item(p, layer, xq, it - QD, smem);
            } else {
              const int j = it - QE;
              mla_item(p, 2 * xq + j / 66, (j % 66 + 2) % 66, smem);
            }
          }
        }
      }
      xcd_barrier(xb);
#pragma unroll 1
      for (int rep = 0; rep < repG; rep++)
      XCD_LOOP(MERGE_FULL, it) merge_item(p, hb, layer, it, smem);
      for (int it = MERGE_FULL + bid; it < MERGE_ITEMS; it += nblk) merge_item(p, hb, layer, it, smem);
      xcd_barrier(xb);
      XCD_LOOP(RES_FULL, it) resid_item(p, g, layer, it, p.mbuf, D, p.wo_t, 2 * D, smem);
      for (int it = RES_FULL + bid; it < RES_ITEMS; it += nblk) resid_item(p, g, layer, it, p.mbuf, D, p.wo_t, 2 * D, smem);
      xcd_barrier(xb);
      rowpass_rows(p, hb, g, rp0, rp1, 1, 1, p.ln1_g + layer * D, p.ln1_b + layer * D, layer, 3 * D, true);
      xcd_barrier(xb);
#pragma unroll 1
      for (int rep = 0; rep < repG; rep++)
      XCD_LOOP_SPREAD(MT * 22, it) ffn1_item(p, hb, it, smem);
      xcd_barrier(xb);
      XCD_LOOP(RES_FULL, it) resid_item(p, g, layer, it, p.hid, FFH, p.wff2_t, 5 * D, smem);
      for (int it = RES_FULL + bid; it < RES_ITEMS; it += nblk) resid_item(p, g, layer, it, p.hid, FFH, p.wff2_t, 5 * D, smem);
      xcd_barrier(xb);
      {
        const bool last_layer = layer == DEPTH - 1;
        rowpass_rows(p, hb, g, rp0, rp1, 1, 1, p.ln2_g + layer * D, p.ln2_b + layer * D, layer + 1, 0, !last_layer);
        if (g == NGRP - 1 && !last_layer)
          for (int it = bid; it < CV_TOTAL; it += nblk) conv_item(p, layer + 1, it, smem);
      }
      xcd_barrier(xb);
    }
  }
}

static inline size_t align_up(size_t v) { return (v + 255) & ~(size_t)255; }

extern "C" void kernel_launch(void* const* d_in, const int* in_sizes, int n_in, void* d_out, int out_size, void* d_ws,
                              size_t ws_size, hipStream_t stream) {
  static int grid_blocks = 0;
  if (!grid_blocks) {
    int dev = 0, cus = 0, per_cu = 0;
    hipGetDevice(&dev);
    hipDeviceGetAttribute(&cus, hipDeviceAttributeMultiprocessorCount, dev);
    hipOccupancyMaxActiveBlocksPerMultiprocessor(&per_cu, mega_kernel, 256, 0);
    if (per_cu > 2) per_cu = 2;
    if (per_cu < 1) per_cu = 1;
    grid_blocks = cus * per_cu;
  }
  Params p{};
  const float* const* in = (const float* const*)d_in;
  p.x = in[0]; p.c = in[1]; p.ctx = in[2]; p.c_ctx = in[3]; p.w_mod = in[4]; p.b_mod = in[5]; p.w_in = in[6];
  p.qn = in[7]; p.kvn = in[8]; p.w_uq = in[9]; p.w_ukv = in[10]; p.lb_logits = in[11]; p.hg_norm = in[12];
  p.diff_lambda = in[13]; p.diff_subln = in[14]; p.w_branch = in[15]; p.w_gate = in[16]; p.b_gate = in[17];
  p.w_o = in[18]; p.ln1_g = in[19]; p.ln1_b = in[20]; p.w_ff1 = in[21]; p.w_ff2 = in[22]; p.ln2_g = in[23]; p.ln2_b = in[24];
  p.out = (float*)d_out;
  char* ws = (char*)d_ws;
  size_t off = 0;
  auto take = [&](size_t bytes) { char* r = ws + off; off = align_up(off + bytes); return r; };
  p.mod = (float*)take((size_t)DEPTH * 5 * 6 * D * 4);
  p.ctxres = (float*)take((size_t)NBATCH * CTX * D * 4);
  p.win_t = (bf16_t*)take((size_t)INWP * D * 2);
  p.wuq_t = (bf16_t*)take((size_t)768 * 256 * 2);
  p.wukv_t = (bf16_t*)take((size_t)1024 * 128 * 2);
  p.wg_t = (bf16_t*)take((size_t)3 * D * D * 2);
  p.wb_t = (bf16_t*)take((size_t)3 * D * 512 * 2);
  p.wo_t = (bf16_t*)take((size_t)D * D * 2);
  p.wff1_t = (bf16_t*)take((size_t)2 * FFH * D * 2);
  p.wff2_t = (bf16_t*)take((size_t)D * FFH * 2);
  p.h = (bf16_t*)take((size_t)NGRP * TG * D * 2);
  p.cbuf = (bf16_t*)take((size_t)TG * 416 * 2);
  p.Qm = (bf16_t*)take((size_t)TG * 768 * 2);
  p.Km = (bf16_t*)take((size_t)TG * 768 * 2);
  p.mbuf = p.Qm;
  p.Vtm = (bf16_t*)take((size_t)TG * 512 * 2);
  p.hq = (bf16_t*)take((size_t)TG * 512 * 2);
  p.zf = (bf16_t*)take((size_t)TG * 512 * 2);
  p.zb = (bf16_t*)take((size_t)TG * 512 * 2);
  p.hi = (bf16_t*)take((size_t)TG * 512 * 2);
  p.hog = (bf16_t*)take((size_t)TG * 512 * 2);
  p.dq = (bf16_t*)take((size_t)TG * 512 * 2);
  p.hid = p.hq;
  p.dk = (bf16_t*)take((size_t)TG * 512 * 2);
  p.dvt = (bf16_t*)take((size_t)TG * 512 * 2);
  p.gf = (bf16_t*)take((size_t)TG * 512 * 2);
  p.gb = (bf16_t*)take((size_t)TG * 512 * 2);
  p.ymla = (bf16_t*)take((size_t)TG * 512 * 2);
  p.yhg = (bf16_t*)take((size_t)TG * 512 * 2);
  p.ydiff = (bf16_t*)take((size_t)TG * 512 * 2);
  p.hgst = (float*)take((size_t)GB * 4 * 2 * NRNG * 16384 * 4);
  p.hgdec = (float*)take((size_t)GB * 4 * 2 * NRNG * 128 * 4);
  p.osum = (float*)take((size_t)TG * 512 * 4);
  p.stash = (float*)take((size_t)grid_blocks * 64 * 256 * 4);
  p.qctr = (unsigned*)take(256 * 4);
  p.xbar = (unsigned*)take(XCD_BAR_WORDS * 4);
  p.dep = (unsigned*)take((size_t)NGRP * DEPTH * 512 * 4);
  if (off > ws_size) {
    fprintf(stderr, "workspace too small: need %zu have %zu\n", off, ws_size);
    return;
  }
  float li0 = 0.8f - 0.6f * expf(-0.3f * 0.f), li1 = 0.8f - 0.6f * expf(-0.3f * 1.f), li2 = 0.8f - 0.6f * expf(-0.3f * 2.f),
        li3 = 0.8f - 0.6f * expf(-0.3f * 3.f);
  int repD = REP_D, repG = REP_G, repH = REP_H;
  void* args[] = {&p, &li0, &li1, &li2, &li3, &repD, &repG, &repH};
  hipError_t e = hipLaunchCooperativeKernel((void*)mega_kernel, dim3(grid_blocks), dim3(256), args, 0, stream);
  if (e != hipSuccess) fprintf(stderr, "cooperative launch failed: %s (grid %d)\n", hipGetErrorString(e), grid_blocks);
}
```
